# Optimizing an MI355X kernel written in HIP

```python
import jax, jax.numpy as jnp
from jax import lax
import numpy as np

D_MODEL = 2048
BATCH = 2
SEQ = 4096
DEPTH = 2

HEAD_DIM = 128
ROPE_THETA = 10000.0
EPS = 1e-6
MASK_VALUE = -1e30
FORCE_VALUE = 1e9
MIN_FORGET = 1e-6
NSA_HEADS = 6
NSA_KV_HEADS = 2
NSA_REP = NSA_HEADS // NSA_KV_HEADS
CMP_BLOCK = 32
CMP_STRIDE = 16
SEL_BLOCK = 64
N_SEL = 16
WINDOW = 512
Q_BLOCK = 128
GDN_HEADS = 5
CONV_WIDTH = 4
GDN_CHUNK = 64
HGRN_HEADS = 5
HGRN_CHUNK = 64
D_FF = 5632

NSA_WIDTH = NSA_HEADS * HEAD_DIM
KV_WIDTH = NSA_KV_HEADS * HEAD_DIM
GDN_WIDTH = GDN_HEADS * HEAD_DIM
HGRN_WIDTH = HGRN_HEADS * HEAD_DIM
MIX_WIDTH = NSA_WIDTH + GDN_WIDTH + HGRN_WIDTH
IN_SIZES = (NSA_WIDTH, KV_WIDTH, KV_WIDTH, KV_WIDTH, KV_WIDTH, KV_WIDTH, KV_WIDTH, 3 * NSA_HEADS,
            GDN_WIDTH, GDN_WIDTH, GDN_WIDTH, GDN_HEADS, GDN_HEADS, GDN_WIDTH,
            HGRN_WIDTH, HGRN_WIDTH, HGRN_WIDTH, HGRN_WIDTH)
IN_WIDTH = NSA_WIDTH + 6 * KV_WIDTH + 3 * NSA_HEADS + 4 * GDN_WIDTH + 2 * GDN_HEADS + 4 * HGRN_WIDTH

kernel_name = 'hymba_nsa_gdn_hgrn2_macaron'


def rms_norm(x, g):
    xf = x.astype(jnp.float32)
    y = xf * lax.rsqrt(jnp.mean(xf * xf, axis=-1, keepdims=True) + EPS)
    return (y * g.astype(jnp.float32)).astype(x.dtype)


def l2norm(x):
    xf = x.astype(jnp.float32)
    return xf * lax.rsqrt(jnp.sum(xf * xf, axis=-1, keepdims=True) + EPS)


def swiglu(x, w_gate, w_up, w_down):
    return (jax.nn.silu(x @ w_gate) * (x @ w_up)) @ w_down


def split_cols(p, sizes):
    offs = np.cumsum(np.array(sizes))[:-1].tolist()
    return jnp.split(p, offs, axis=-1)


def rope_tables(seq):
    inv = 1.0 / (ROPE_THETA ** (jnp.arange(0, HEAD_DIM, 2, dtype=jnp.float32) / HEAD_DIM))
    ang = jnp.arange(seq, dtype=jnp.float32)[:, None] * inv[None, :]
    return jnp.cos(ang), jnp.sin(ang)


def rope(x, cos, sin):
    xf = x.astype(jnp.float32)
    x1, x2 = jnp.split(xf, 2, axis=-1)
    c = cos[None, :, None, :]
    s = sin[None, :, None, :]
    return jnp.concatenate([x1 * c - x2 * s, x2 * c + x1 * s], axis=-1).astype(x.dtype)


def masked_softmax(s, mask):
    s = jnp.where(mask, s.astype(jnp.float32), MASK_VALUE)
    m = jnp.max(s, axis=-1, keepdims=True)
    e = jnp.where(mask, jnp.exp(s - m), 0.0)
    return e / jnp.maximum(jnp.sum(e, axis=-1, keepdims=True), 1e-30)


def masked_decay(diff, causal):
    return jnp.where(causal, jnp.exp(jnp.where(causal, diff, 0.0)), 0.0)


def causal_conv(x, w):
    c = w.shape[1]
    return lax.conv_general_dilated(x, w[:, None, :].astype(x.dtype), window_strides=(1,),
                                    padding=[(CONV_WIDTH - 1, 0)],
                                    dimension_numbers=('NWC', 'WIO', 'NWC'),
                                    feature_group_count=c)


def nsa_mixer(q, k_c, v_c, k_s, v_s, k_w, v_w, gate_logits, pe_k, pe_v, w_k1, w_k2, w_v1, w_v2, cos, sin):
    B, S = q.shape[0], q.shape[1]
    G, R, D = NSA_KV_HEADS, NSA_REP, HEAD_DIM
    scale = HEAD_DIM ** -0.5
    q = (rope(q.reshape(B, S, NSA_HEADS, D), cos, sin) * scale).reshape(B, S, G, R, D)
    k_c = rope(k_c.reshape(B, S, G, D), cos, sin)
    k_s = rope(k_s.reshape(B, S, G, D), cos, sin)
    k_w = rope(k_w.reshape(B, S, G, D), cos, sin)
    v_c = v_c.reshape(B, S, G, D)
    v_s = v_s.reshape(B, S, G, D)
    v_w = v_w.reshape(B, S, G, D)

    n_cmp = (S - CMP_BLOCK) // CMP_STRIDE + 1
    tok = jnp.arange(n_cmp)[:, None] * CMP_STRIDE + jnp.arange(CMP_BLOCK)[None, :]

    def compress(t, pe, w1, w2):
        blocks = t[:, tok] + pe[None, None, :, None, :]
        flat = blocks.transpose(0, 3, 1, 2, 4).reshape(B, G, n_cmp, CMP_BLOCK * D)
        return jax.nn.gelu(flat @ w1) @ w2

    kc = compress(k_c, pe_k, w_k1, w_k2)
    vc = compress(v_c, pe_v, w_v1, w_v2)
    cmp_end = jnp.arange(n_cmp) * CMP_STRIDE + CMP_BLOCK - 1

    n_blk = S // SEL_BLOCK
    n_sel = min(N_SEL, n_blk)
    c_start = jnp.arange(n_cmp) * CMP_STRIDE
    s_start = jnp.arange(n_blk) * SEL_BLOCK
    ov = (jnp.minimum(c_start[:, None] + CMP_BLOCK, s_start[None, :] + SEL_BLOCK)
          - jnp.maximum(c_start[:, None], s_start[None, :]))
    overlap = jnp.clip(ov, 0, None).astype(jnp.float32) / CMP_BLOCK
    ksb = k_s.reshape(B, n_blk, SEL_BLOCK, G, D).transpose(0, 3, 1, 2, 4)
    vsb = v_s.reshape(B, n_blk, SEL_BLOCK, G, D).transpose(0, 3, 1, 2, 4)

    kw = jnp.pad(k_w.transpose(0, 2, 1, 3), ((0, 0), (0, 0), (WINDOW, 0), (0, 0)))
    vw = jnp.pad(v_w.transpose(0, 2, 1, 3), ((0, 0), (0, 0), (WINDOW, 0), (0, 0)))

    n_qb = S // Q_BLOCK
    qb = q.reshape(B, n_qb, Q_BLOCK, G, R, D).transpose(1, 0, 3, 4, 2, 5)
    gb = jax.nn.sigmoid(gate_logits.astype(jnp.float32)).reshape(B, n_qb, Q_BLOCK, G, R, 3)
    gb = gb.transpose(1, 0, 3, 4, 2, 5)
    b_idx = jnp.arange(B)[:, None, None, None]
    g_idx = jnp.arange(G)[None, :, None, None]
    blk = jnp.arange(n_blk)
    sel_off = jnp.arange(SEL_BLOCK)
    win_off = jnp.arange(Q_BLOCK + WINDOW)

    def block(args):
        i, qi, gt = args
        t = i * Q_BLOCK + jnp.arange(Q_BLOCK)
        s_c = jnp.einsum('bgrqd,bgnd->bgrqn', qi, kc).astype(jnp.float32)
        p_c = masked_softmax(s_c, cmp_end[None, :] <= t[:, None])
        o_c = jnp.einsum('bgrqn,bgnd->bgrqd', p_c.astype(vc.dtype), vc)
        imp = jnp.einsum('bgqn,nm->bgqm', jnp.sum(p_c, axis=2), overlap)
        cur = t // SEL_BLOCK
        forced = ((blk[None, :] == 0) | (blk[None, :] == cur[:, None])
                  | (blk[None, :] == cur[:, None] - 1))
        future = blk[None, :] * SEL_BLOCK > t[:, None]
        imp = jnp.where(forced, FORCE_VALUE, jnp.where(future, -FORCE_VALUE, imp))
        _, idx = lax.top_k(imp, n_sel)
        k_sel = ksb[b_idx, g_idx, idx].reshape(B, G, Q_BLOCK, n_sel * SEL_BLOCK, D)
        v_sel = vsb[b_idx, g_idx, idx].reshape(B, G, Q_BLOCK, n_sel * SEL_BLOCK, D)
        kpos = (idx[..., None] * SEL_BLOCK + sel_off).reshape(B, G, 1, Q_BLOCK, n_sel * SEL_BLOCK)
        s_s = jnp.einsum('bgrqd,bgqmd->bgrqm', qi, k_sel).astype(jnp.float32)
        p_s = masked_softmax(s_s, kpos <= t[None, None, None, :, None])
        o_s = jnp.einsum('bgrqm,bgqmd->bgrqd', p_s.astype(v_sel.dtype), v_sel)
        k_win = lax.dynamic_slice_in_dim(kw, i * Q_BLOCK, Q_BLOCK + WINDOW, axis=2)
        v_win = lax.dynamic_slice_in_dim(vw, i * Q_BLOCK, Q_BLOCK + WINDOW, axis=2)
        wpos = i * Q_BLOCK - WINDOW + win_off
        mask_w = ((wpos[None, :] <= t[:, None]) & (wpos[None, :] > t[:, None] - WINDOW)
                  & (wpos[None, :] >= 0))
        s_w = jnp.einsum('bgrqd,bgkd->bgrqk', qi, k_win).astype(jnp.float32)
        p_w = masked_softmax(s_w, mask_w)
        o_w = jnp.einsum('bgrqk,bgkd->bgrqd', p_w.astype(v_win.dtype), v_win)
        o = gt[..., 0:1] * o_c + gt[..., 1:2] * o_s + gt[..., 2:3] * o_w
        return o.astype(qi.dtype)

    o = lax.map(block, (jnp.arange(n_qb), qb, gb))
    return o.transpose(1, 0, 4, 2, 3, 5).reshape(B, S, NSA_WIDTH)


def chunk_gated_delta(q, k, v, g, beta):
    B, S, H, D = q.shape
    C = GDN_CHUNK
    n = S // C

    def chunks(a):
        return a.reshape(B, n, C, H, D).transpose(0, 3, 1, 2, 4)

    q, k, v = chunks(q), chunks(k), chunks(v)
    g = g.reshape(B, n, C, H).transpose(0, 3, 1, 2)
    beta = beta.reshape(B, n, C, H).transpose(0, 3, 1, 2)
    gc = jnp.cumsum(g, axis=-1)
    causal = jnp.tril(jnp.ones((C, C), dtype=bool))
    strict = jnp.tril(jnp.ones((C, C), dtype=bool), -1)
    decay = masked_decay(gc[..., :, None] - gc[..., None, :], causal)
    kb = k * beta[..., None]
    A = jnp.where(strict, jnp.einsum('bhnid,bhnjd->bhnij', kb, k) * decay, 0.0)
    rhs = jnp.concatenate([v * beta[..., None], kb * jnp.exp(gc)[..., None]], axis=-1)
    sol = lax.linalg.triangular_solve(A, rhs, left_side=True, lower=True, unit_diagonal=True)
    u, w = sol[..., :D], sol[..., D:]
    attn = jnp.einsum('bhnid,bhnjd->bhnij', q, k) * decay
    q_dec = q * jnp.exp(gc)[..., None]
    k_dec = k * jnp.exp(gc[..., -1:] - gc)[..., None]
    last = jnp.exp(gc[..., -1])

    def step(state, xs):
        u_, w_, qd, kd, at, ld = xs
        v_new = u_ - jnp.einsum('bhcd,bhde->bhce', w_, state)
        o = jnp.einsum('bhcd,bhde->bhce', qd, state) + jnp.einsum('bhij,bhje->bhie', at, v_new)
        state = state * ld[..., None, None] + jnp.einsum('bhcd,bhce->bhde', kd, v_new)
        return state, o

    xs = tuple(jnp.moveaxis(a, 2, 0) for a in (u, w, q_dec, k_dec, attn, last))
    _, o = lax.scan(step, jnp.zeros((B, H, D, D), jnp.float32), xs)
    return o.transpose(1, 0, 3, 2, 4).reshape(B, S, H, D)


def gated_deltanet(q, k, v, a, b, z, w_conv, a_log, dt_bias, norm_w):
    B, S = q.shape[0], q.shape[1]
    H, D = GDN_HEADS, HEAD_DIM
    qkv = jax.nn.silu(causal_conv(jnp.concatenate([q, k, v], axis=-1), w_conv))
    q, k, v = jnp.split(qkv, 3, axis=-1)
    q = l2norm(q.reshape(B, S, H, D)) * (HEAD_DIM ** -0.5)
    k = l2norm(k.reshape(B, S, H, D))
    v = v.reshape(B, S, H, D).astype(jnp.float32)
    beta = jax.nn.sigmoid(b.astype(jnp.float32))
    g = -jnp.exp(a_log.astype(jnp.float32)) * jax.nn.softplus(a.astype(jnp.float32) + dt_bias.astype(jnp.float32))
    o = chunk_gated_delta(q, k, v, g, beta)
    o = rms_norm(o, norm_w) * jax.nn.silu(z.reshape(B, S, H, D).astype(jnp.float32))
    return o.reshape(B, S, GDN_WIDTH).astype(z.dtype)


def chunk_hgrn2(q, k, v, log_f):
    B, S, H, D = q.shape
    C = HGRN_CHUNK
    n = S // C

    def chunks(a):
        return a.reshape(B, n, C, H, D).transpose(1, 0, 3, 2, 4)

    causal = jnp.tril(jnp.ones((C, C), dtype=bool))[:, :, None]

    def step(state, xs):
        q_, k_, v_, lf = xs
        bcum = jnp.cumsum(lf, axis=-2)
        dec = masked_decay(bcum[..., :, None, :] - bcum[..., None, :, :], causal)
        A = jnp.einsum('bhid,bhjd,bhijd->bhij', q_, k_, dec)
        o = jnp.einsum('bhid,bhde->bhie', q_ * jnp.exp(bcum), state) + jnp.einsum('bhij,bhje->bhie', A, v_)
        b_last = bcum[..., -1:, :]
        state = (state * jnp.exp(bcum[..., -1, :])[..., None]
                 + jnp.einsum('bhjd,bhje->bhde', k_ * jnp.exp(b_last - bcum), v_))
        return state, o

    xs = (chunks(q), chunks(k), chunks(v), chunks(log_f))
    _, o = lax.scan(step, jnp.zeros((B, H, D, D), jnp.float32), xs)
    return o.transpose(1, 0, 3, 2, 4).reshape(B, S, H, D)


def hgrn2(q, f, i, g, lb, norm_w):
    B, S = q.shape[0], q.shape[1]
    H, D = HGRN_HEADS, HEAD_DIM
    f_gate = lb + (1.0 - lb) * jax.nn.sigmoid(f.astype(jnp.float32))
    log_f = jnp.log(jnp.maximum(f_gate, MIN_FORGET))
    k = 1.0 - f_gate
    shp = (B, S, H, D)
    o = chunk_hgrn2(q.astype(jnp.float32).reshape(shp), k.reshape(shp),
                    i.astype(jnp.float32).reshape(shp), log_f.reshape(shp))
    o = rms_norm(o, norm_w) * jax.nn.silu(g.reshape(shp).astype(jnp.float32))
    return o.reshape(B, S, HGRN_WIDTH).astype(g.dtype)


def setup_inputs(seed: int = 0) -> dict:
    key = jax.random.key(seed)
    keys = iter(jax.random.split(key, 48))

    def nrm(shape, scale):
        return jax.random.normal(next(keys), shape, jnp.float32) * scale

    def gain(shape):
        return 1.0 + 0.02 * jax.random.normal(next(keys), shape, jnp.float32)

    dt = jax.random.uniform(next(keys), (DEPTH, GDN_HEADS), jnp.float32, 0.001, 0.1)
    return {
        'x': jax.random.normal(next(keys), (BATCH, SEQ, D_MODEL), jnp.float32),
        'ffn1_norm': gain((DEPTH, D_MODEL)),
        'ffn1_gate': nrm((DEPTH, D_MODEL, D_FF), D_MODEL ** -0.5),
        'ffn1_up': nrm((DEPTH, D_MODEL, D_FF), D_MODEL ** -0.5),
        'ffn1_down': nrm((DEPTH, D_FF, D_MODEL), D_FF ** -0.5),
        'mix_norm': gain((DEPTH, D_MODEL)),
        'w_in': nrm((DEPTH, D_MODEL, IN_WIDTH), D_MODEL ** -0.5),
        'w_out': nrm((DEPTH, MIX_WIDTH, D_MODEL), MIX_WIDTH ** -0.5),
        'nsa_pe_k': nrm((DEPTH, CMP_BLOCK, HEAD_DIM), 0.1),
        'nsa_pe_v': nrm((DEPTH, CMP_BLOCK, HEAD_DIM), 0.1),
        'nsa_ck1': nrm((DEPTH, CMP_BLOCK * HEAD_DIM, HEAD_DIM), (CMP_BLOCK * HEAD_DIM) ** -0.5),
        'nsa_ck2': nrm((DEPTH, HEAD_DIM, HEAD_DIM), HEAD_DIM ** -0.5),
        'nsa_cv1': nrm((DEPTH, CMP_BLOCK * HEAD_DIM, HEAD_DIM), (CMP_BLOCK * HEAD_DIM) ** -0.5),
        'nsa_cv2': nrm((DEPTH, HEAD_DIM, HEAD_DIM), HEAD_DIM ** -0.5),
        'gdn_conv': nrm((DEPTH, CONV_WIDTH, 3 * GDN_WIDTH), CONV_WIDTH ** -0.5),
        'gdn_a_log': jnp.log(jax.random.uniform(next(keys), (DEPTH, GDN_HEADS), jnp.float32, 1.0, 16.0)),
        'gdn_dt_bias': dt + jnp.log(-jnp.expm1(-dt)),
        'gdn_norm': gain((DEPTH, HEAD_DIM)),
        'hgrn_lb': nrm((DEPTH, HGRN_WIDTH), 0.5),
        'hgrn_norm': gain((DEPTH, HEAD_DIM)),
        'ffn2_norm': gain((DEPTH, D_MODEL)),
        'ffn2_gate': nrm((DEPTH, D_MODEL, D_FF), D_MODEL ** -0.5),
        'ffn2_up': nrm((DEPTH, D_MODEL, D_FF), D_MODEL ** -0.5),
        'ffn2_down': nrm((DEPTH, D_FF, D_MODEL), D_FF ** -0.5),
        'final_norm': gain((D_MODEL,)),
    }


def reference(x, ffn1_norm, ffn1_gate, ffn1_up, ffn1_down, mix_norm, w_in, w_out,
              nsa_pe_k, nsa_pe_v, nsa_ck1, nsa_ck2, nsa_cv1, nsa_cv2,
              gdn_conv, gdn_a_log, gdn_dt_bias, gdn_norm, hgrn_lb, hgrn_norm,
              ffn2_norm, ffn2_gate, ffn2_up, ffn2_down, final_norm):
    cos, sin = rope_tables(x.shape[1])
    p_lb = jax.nn.softmax(hgrn_lb.astype(jnp.float32), axis=0)
    lb_all = jnp.cumsum(p_lb, axis=0) - p_lb[0:1]
    for l in range(DEPTH):
        x = x + 0.5 * swiglu(rms_norm(x, ffn1_norm[l]), ffn1_gate[l], ffn1_up[l], ffn1_down[l])
        h = rms_norm(x, mix_norm[l])
        (nq, nkc, nvc, nks, nvs, nkw, nvw, ngt,
         gq, gk, gv, ga, gbeta, gz,
         hq, hf, hi, hg) = split_cols(h @ w_in[l], IN_SIZES)
        y_nsa = nsa_mixer(nq, nkc, nvc, nks, nvs, nkw, nvw, ngt, nsa_pe_k[l], nsa_pe_v[l],
                          nsa_ck1[l], nsa_ck2[l], nsa_cv1[l], nsa_cv2[l], cos, sin)
        y_gdn = gated_deltanet(gq, gk, gv, ga, gbeta, gz, gdn_conv[l], gdn_a_log[l], gdn_dt_bias[l], gdn_norm[l])
        y_hgrn = hgrn2(hq, hf, hi, hg, lb_all[l], hgrn_norm[l])
        y = jnp.concatenate([y_nsa.astype(x.dtype), y_gdn.astype(x.dtype), y_hgrn.astype(x.dtype)], axis=-1)
        x = x + y @ w_out[l]
        x = x + 0.5 * swiglu(rms_norm(x, ffn2_norm[l]), ffn2_gate[l], ffn2_up[l], ffn2_down[l])
    return rms_norm(x, final_norm)
```

```cpp
#include <hip/hip_runtime.h>
#include <hip/hip_cooperative_groups.h>
#include <cstdio>
#include <cstdint>
namespace cg = cooperative_groups;

typedef unsigned short bf16_t;
typedef short bf16x8 __attribute__((ext_vector_type(8)));
typedef float f32x4 __attribute__((ext_vector_type(4)));
typedef unsigned u32x4 __attribute__((ext_vector_type(4)));
typedef unsigned u32x2 __attribute__((ext_vector_type(2)));

constexpr int DM = 2048, NB = 2, SEQ = 4096, NT = NB * SEQ, DEPTH = 2, FF = 5632, HD = 128;
constexpr int INW = 7452, INP = 7680;
constexpr int C_NQ = 0, C_NKC = 768, C_NVC = 1024, C_NKS = 1280, C_NVS = 1536, C_NKW = 1792, C_NVW = 2048;
constexpr int C_GQ = 2304, C_GK = 2944, C_GV = 3584, C_GZ = 4224, C_HQ = 4864, C_HF = 5504, C_HI = 6144, C_HG = 6784;
constexpr int C_NGT = 7424, C_GA = 7442, C_GB = 7447;
constexpr int NCH = 64;
constexpr int NCI = NB * 5 * NCH;

constexpr size_t al(size_t x) { return (x + 255) & ~(size_t)255; }
constexpr size_t WS_CTL = 0;
constexpr size_t WS_BAR = 4096;
constexpr size_t WS_WGU1 = 32768;
constexpr size_t WS_WD1 = WS_WGU1 + (size_t)2 * FF * DM * 2;
constexpr size_t WS_WGU2 = WS_WD1 + (size_t)DM * FF * 2;
constexpr size_t WS_WD2 = WS_WGU2 + (size_t)2 * FF * DM * 2;
constexpr size_t WS_WIN = WS_WD2 + (size_t)DM * FF * 2;
constexpr size_t WS_WOUT = WS_WIN + (size_t)INP * DM * 2;
constexpr size_t WS_CK1 = WS_WOUT + (size_t)DM * DM * 2;
constexpr size_t WS_CV1 = WS_CK1 + (size_t)128 * 4096 * 2;
constexpr size_t WS_CK2 = WS_CV1 + (size_t)128 * 4096 * 2;
constexpr size_t WS_CV2 = WS_CK2 + (size_t)128 * 128 * 2;
constexpr size_t WS_XN = WS_CV2 + (size_t)128 * 128 * 2;
constexpr size_t WS_Y = WS_XN + (size_t)NT * DM * 2;
constexpr size_t WS_P = WS_Y + (size_t)NT * DM * 2;
constexpr size_t WS_QB = WS_P + (size_t)NT * INP * 4;
constexpr size_t WS_KCR = WS_QB + (size_t)NT * 768 * 2;
constexpr size_t WS_VCR = WS_KCR + (size_t)NT * 256 * 4;
constexpr size_t WS_KS = WS_VCR + (size_t)NT * 256 * 4;
constexpr size_t WS_KW = WS_KS + (size_t)NT * 256 * 2;
constexpr size_t WS_VST = WS_KW + (size_t)NT * 256 * 2;
constexpr size_t WS_VWT = WS_VST + (size_t)NT * 256 * 2;
constexpr size_t WS_KCB = WS_VWT + (size_t)NT * 256 * 2;
constexpr size_t WS_VCT = WS_KCB + (size_t)4 * 256 * 128 * 2;
constexpr size_t WS_GT = WS_VCT + (size_t)4 * 256 * 128 * 2;
constexpr size_t WS_ONSA = WS_GT + (size_t)NT * 32 * 4;
constexpr size_t WS_GU = WS_ONSA + (size_t)NT * 768 * 4;
constexpr size_t WS_GWN = WS_GU + (size_t)NCI * 64 * 128 * 4;
constexpr size_t WS_GQD = WS_GWN + (size_t)NCI * 64 * 128 * 2;
constexpr size_t WS_GKT = WS_GQD + (size_t)NCI * 64 * 128 * 2;
constexpr size_t WS_GAT = WS_GKT + (size_t)NCI * 64 * 128 * 2;
constexpr size_t WS_GLAST = WS_GAT + (size_t)NCI * 64 * 64 * 2;
constexpr size_t WS_HQE = WS_GLAST + al((size_t)NCI * 4);
constexpr size_t WS_HKT = WS_HQE + (size_t)NCI * 64 * 128 * 2;
constexpr size_t WS_HAM = WS_HKT + (size_t)NCI * 64 * 128 * 2;
constexpr size_t WS_HVT = WS_HAM + (size_t)NCI * 64 * 64 * 2;
constexpr size_t WS_HDL = WS_HVT + (size_t)NCI * 64 * 128 * 2;
constexpr size_t WS_OG = WS_HDL + (size_t)NCI * 128 * 4;
constexpr size_t WS_OH = WS_OG + (size_t)NT * 640 * 4;
constexpr size_t WS_LB = WS_OH + (size_t)NT * 640 * 4;
constexpr size_t WS_ONC = WS_LB + al((size_t)2 * 640 * 4);
constexpr size_t WS_MSK = WS_ONC + (size_t)NT * 768 * 4;
constexpr size_t WS_SSQ = WS_MSK + al((size_t)128 * 130 * 8);
constexpr size_t WS_END = WS_SSQ + (size_t)6 * NT * 8 * 4;

constexpr int LDS_BYTES = 160 * 1024;

struct Args {
    const float* in[25];
    float* out;
    unsigned char* ws;
    int ph_lo, ph_hi;
};

__device__ __forceinline__ int opaque_tid() { int t = threadIdx.x; asm volatile("" : "+v"(t)); return t; }
__device__ __forceinline__ int opaque_bid() { int t = blockIdx.x; asm volatile("" : "+s"(t)); return t; }
__device__ __forceinline__ int opaque_gdim() { int t = gridDim.x; asm volatile("" : "+s"(t)); return t; }
typedef const __attribute__((address_space(4))) unsigned char* kas_ptr;
__device__ __forceinline__ unsigned long long karg_u64(int byte_off) {
    kas_ptr kp = (kas_ptr)__builtin_amdgcn_kernarg_segment_ptr();
    asm volatile("" : "+s"(kp));
    return *(const __attribute__((address_space(4))) unsigned long long*)(kp + byte_off);
}
#define TIDX opaque_tid()
#define BIDX opaque_bid()
#define GDIM opaque_gdim()
#define AIN(i) ((const float*)(__attribute__((address_space(1))) const float*)karg_u64(8 * (i)))
#define AOUT ((float*)(__attribute__((address_space(1))) float*)karg_u64(200))
#define AWS ((unsigned char*)karg_u64(208))
__device__ __forceinline__ unsigned short f2bf(float f) { __bf16 b = (__bf16)f; return __builtin_bit_cast(unsigned short, b); }
typedef float f32x2_t __attribute__((ext_vector_type(2)));
typedef __bf16 bf16x2_t __attribute__((ext_vector_type(2)));
__device__ __forceinline__ unsigned pk2(float lo, float hi) { f32x2_t v = {lo, hi}; bf16x2_t b = __builtin_convertvector(v, bf16x2_t); return __builtin_bit_cast(unsigned, b); }
__device__ __forceinline__ float bf2f(unsigned short h) { return __uint_as_float(((unsigned)h) << 16); }
__device__ __forceinline__ float wave_sum(float v) {
#pragma unroll
    for (int o = 1; o < 64; o <<= 1) v += __shfl_xor(v, o);
    return v;
}
__device__ __forceinline__ float sigmoidf_(float x) { return __builtin_amdgcn_rcpf(1.f + __expf(-x)); }
__device__ __forceinline__ float siluf_(float x) { return x * __builtin_amdgcn_rcpf(1.f + __expf(-x)); }
__device__ __forceinline__ const float* sel_ptr(bool c, const float* x, const float* y) {
    unsigned long long xv = (unsigned long long)x, yv = (unsigned long long)y;
    asm volatile("" : "+s"(xv), "+s"(yv));
    return (const float*)(c ? xv : yv);
}
__device__ __forceinline__ float ldnt(const float* p) { return __builtin_nontemporal_load(p); }
__device__ __forceinline__ void lds_barrier() { asm volatile("s_waitcnt lgkmcnt(0)\n\ts_barrier" ::: "memory"); }
__device__ __forceinline__ unsigned xb_ld(unsigned* p)              { return __hip_atomic_load(p, __ATOMIC_RELAXED, __HIP_MEMORY_SCOPE_AGENT); }
__device__ __forceinline__ unsigned xb_add(unsigned* p, unsigned v) { return __hip_atomic_fetch_add(p, v, __ATOMIC_RELAXED, __HIP_MEMORY_SCOPE_AGENT); }
__device__ __forceinline__ f32x4 zero4() {
    int z = 0; asm volatile("" : "+s"(z));
    const float zf = __int_as_float(z);
    return (f32x4){zf, zf, zf, zf};
}
__device__ __forceinline__ f32x4 mfma16(bf16x8 a, bf16x8 b, f32x4 c) { return __builtin_amdgcn_mfma_f32_16x16x32_bf16(a, b, c, 0, 0, 0); }

__device__ __forceinline__ int win_newcol(int o) {
    if (o < 2304) return o;
    if (o < 2322) return C_NGT + (o - 2304);
    if (o < 4242) return C_GQ + (o - 2322);
    if (o < 4247) return C_GA + (o - 4242);
    if (o < 4252) return C_GB + (o - 4247);
    return C_GZ + (o - 4252);
}
__device__ __forceinline__ int rowmap(int mode, int n) {
    if (mode == 0) return n;
    if (mode == 1) return (n >> 7) * 256 + (n & 127);
    if (mode == 2) return (n >> 7) * 256 + 128 + (n & 127);
    return win_newcol(n);
}
__device__ __forceinline__ void conv_tile(const float* W, int K, int N, bf16_t* WT, int mode, int tile, float* scr) {
    const int nbn = (N + 63) / 64, kb = tile / nbn, nb = tile % nbn, k0 = kb * 64, n0 = nb * 64;
    const int tid = TIDX;
    __syncthreads();
#pragma unroll
    for (int i = 0; i < 8; ++i) {
        const int kk = i * 8 + (tid >> 6), nn = tid & 63;
        float v = 0.f;
        if (n0 + nn < N) v = W[(size_t)(k0 + kk) * N + n0 + nn];
        scr[nn * 65 + kk] = v;
    }
    __syncthreads();
    const int nn = tid >> 3, kc = (tid & 7) * 8;
    if (n0 + nn < N) {
        const float* s = scr + nn * 65 + kc;
        u32x4 o; o.x = pk2(s[0], s[1]); o.y = pk2(s[2], s[3]); o.z = pk2(s[4], s[5]); o.w = pk2(s[6], s[7]);
        *(u32x4*)(WT + (size_t)rowmap(mode, n0 + nn) * K + k0 + kc) = o;
    }
}

__device__ __forceinline__ void rms_rows_bf16(const float* x, const float* g, bf16_t* out, int gw, int ngw) {
    const int lane = TIDX & 63;
    for (int r = gw; r < NT; r += ngw) {
        const f32x4* xr = (const f32x4*)(x + (size_t)r * DM) + lane;
        f32x4 v[8]; float s = 0.f;
#pragma unroll
        for (int j = 0; j < 8; ++j) { v[j] = xr[64 * j]; s += v[j].x * v[j].x + v[j].y * v[j].y + v[j].z * v[j].z + v[j].w * v[j].w; }
        const float rs = rsqrtf(wave_sum(s) * (1.f / DM) + 1e-6f);
        u32x2* o = (u32x2*)(out + (size_t)r * DM) + lane;
#pragma unroll
        for (int j = 0; j < 8; ++j) {
            const f32x4 gg = ((const f32x4*)g)[lane + 64 * j];
            u32x2 w; w.x = pk2(v[j].x * rs * gg.x, v[j].y * rs * gg.y); w.y = pk2(v[j].z * rs * gg.z, v[j].w * rs * gg.w);
            o[64 * j] = w;
        }
    }
}

namespace gm {
constexpr int BM = 256, BK = 64, HALF = 128, NXCD = 8, WGM = 8, HT = HALF * BK;
__device__ __forceinline__ int lds_byte(int r, int c) {
    int st = (r >> 4) * 2 + (c >> 5), rr = r & 15, cc = c & 31, ob = rr * 64 + cc * 2;
    return st * 1024 + (ob ^ (((ob >> 9) & 1) << 5));
}
__device__ __forceinline__ void stage_rc(int b, int& R, int& C) {
    int st = b / 1024, sb = b % 1024, swz = sb ^ (((sb >> 9) & 1) << 5);
    R = (st >> 1) * 16 + swz / 64; C = (st & 1) * 32 + (swz % 64) / 2;
}
enum { EPI_SWIGLU = 0, EPI_RESID = 1, EPI_STORE = 2 };

template <int EPI>
__device__ __forceinline__ void epilogue(const f32x4 (&acc)[2][2][4][2], int brow, int bcol, float* __restrict__ Cf, bf16_t* __restrict__ Cb, int ldc, float scale,
                                         const float* __restrict__ gvec, bf16_t* __restrict__ XNout, float* __restrict__ ssq_out, const float* __restrict__ ssq_in, float* sred) {
    int tz = threadIdx.x; asm volatile("" : "+v"(tz));
    const int wid = tz >> 6, lane = tz & 63, wr = wid >> 2, wc = wid & 3, fr = lane & 15, fq = lane >> 4;
    const int row0 = brow + wr * 64 + fr;
    if (EPI == EPI_SWIGLU || EPI == EPI_STORE) {
        float rs[2][4];
#pragma unroll
        for (int ai = 0; ai < 2; ++ai)
#pragma unroll
            for (int m = 0; m < 4; ++m) {
                const f32x4 q0 = *(const f32x4*)(ssq_in + (size_t)(row0 + ai * HALF + m * 16) * 8), q1 = *(const f32x4*)(ssq_in + (size_t)(row0 + ai * HALF + m * 16) * 8 + 4);
                rs[ai][m] = rsqrtf((((q0.x + q0.y) + (q0.z + q0.w)) + ((q1.x + q1.y) + (q1.z + q1.w))) * (1.f / DM) + 1e-6f);
            }
        if (EPI == EPI_SWIGLU) {
            bf16_t* base = Cb + (size_t)row0 * ldc + (bcol >> 1) + wc * 32 + 4 * fq;
#pragma unroll
            for (int ai = 0; ai < 2; ++ai)
#pragma unroll
                for (int m = 0; m < 4; ++m)
#pragma unroll
                    for (int n = 0; n < 2; ++n) {
                        const f32x4 g = acc[ai][0][m][n] * rs[ai][m], u = acc[ai][1][m][n] * rs[ai][m];
                        u32x2 o; o.x = pk2(siluf_(g.x) * u.x, siluf_(g.y) * u.y); o.y = pk2(siluf_(g.z) * u.z, siluf_(g.w) * u.w);
                        *(u32x2*)(base + (size_t)(ai * HALF + m * 16) * ldc + n * 16) = o;
                    }
        } else {
            float* base = Cf + (size_t)row0 * ldc + bcol + wc * 32 + 4 * fq;
#pragma unroll
            for (int ai = 0; ai < 2; ++ai)
#pragma unroll
                for (int m = 0; m < 4; ++m)
#pragma unroll
                    for (int bj = 0; bj < 2; ++bj)
#pragma unroll
                        for (int n = 0; n < 2; ++n) *(f32x4*)(base + (size_t)(ai * HALF + m * 16) * ldc + bj * HALF + n * 16) = acc[ai][bj][m][n] * rs[ai][m];
        }
    } else {
        const int col0 = bcol + wc * 32 + 4 * fq;
        float* base = Cf + (size_t)row0 * ldc + col0;
        f32x4 gg[2][2];
        if (gvec) {
#pragma unroll
            for (int bj = 0; bj < 2; ++bj)
#pragma unroll
                for (int n = 0; n < 2; ++n) gg[bj][n] = *(const f32x4*)(gvec + col0 + bj * HALF + n * 16);
        }
#pragma unroll
        for (int ai = 0; ai < 2; ++ai) {
            f32x4 xv[4][2][2];
#pragma unroll
            for (int m = 0; m < 4; ++m)
#pragma unroll
                for (int bj = 0; bj < 2; ++bj)
#pragma unroll
                    for (int n = 0; n < 2; ++n) xv[m][bj][n] = *(const f32x4*)(base + (size_t)(ai * HALF + m * 16) * ldc + bj * HALF + n * 16);
#pragma unroll
            for (int m = 0; m < 4; ++m) {
                float ss = 0.f;
#pragma unroll
                for (int bj = 0; bj < 2; ++bj)
#pragma unroll
                    for (int n = 0; n < 2; ++n) {
                        const f32x4 xn = xv[m][bj][n] + acc[ai][bj][m][n] * scale;
                        *(f32x4*)(base + (size_t)(ai * HALF + m * 16) * ldc + bj * HALF + n * 16) = xn;
                        if (gvec) {
                            ss += xn.x * xn.x + xn.y * xn.y + xn.z * xn.z + xn.w * xn.w;
                            u32x2 o; o.x = pk2(xn.x * gg[bj][n].x, xn.y * gg[bj][n].y); o.y = pk2(xn.z * gg[bj][n].z, xn.w * gg[bj][n].w);
                            *(u32x2*)(XNout + (size_t)(row0 + ai * HALF + m * 16) * ldc + col0 + bj * HALF + n * 16) = o;
                        }
                    }
                if (gvec) {
                    ss += __shfl_xor(ss, 16); ss += __shfl_xor(ss, 32);
                    if (fq == 0) sred[(ai * HALF + wr * 64 + m * 16 + fr) * 4 + wc] = ss;
                }
            }
        }
        if (gvec) {
            lds_barrier();
            if (tz < 256) { const f32x4 p = *(const f32x4*)(sred + tz * 4); ssq_out[(size_t)(brow + tz) * 8 + (bcol >> 8)] = (p.x + p.y) + (p.z + p.w); }
        }
    }
}

template <int EPI>
__device__ __forceinline__ void gemm_unit(const bf16_t* A, const bf16_t* Bt, int K, int brow, int bcol, bf16_t* shm,
                                          float* Cf, bf16_t* Cb, int ldc, float scale, const float* gvec, bf16_t* XNout, float* ssq_out, const float* ssq_in) {
#define SA(b, h) (shm + ((b) * 2 + (h)) * HT)
#define SB(b, h) (shm + (4 + (b) * 2 + (h)) * HT)
#define STAGE(P, BASE, br, kt) do { const bf16_t* _gb = (BASE) + ((long)(br) * K + (long)(kt) * BK); \
    __builtin_amdgcn_global_load_lds((const unsigned*)(_gb + so0), (__attribute__((address_space(3))) unsigned*)((char*)(P) + tzz * 16), 16, 0, 0); \
    __builtin_amdgcn_global_load_lds((const unsigned*)(_gb + so1), (__attribute__((address_space(3))) unsigned*)((char*)(P) + tzz * 16 + 8192), 16, 0, 0); } while (0)
#define LDA(dst, b, h) for (int m = 0; m < 4; ++m) for (int k = 0; k < 2; ++k) \
    dst[m][k] = *reinterpret_cast<const bf16x8*>((char*)SA(b, h) + lds_byte(wr * 64 + m * 16 + fr, k * 32 + fq * 8))
#define LDB(dst, b, h) for (int n = 0; n < 2; ++n) for (int k = 0; k < 2; ++k) \
    dst[n][k] = *reinterpret_cast<const bf16x8*>((char*)SB(b, h) + lds_byte(wc * 32 + n * 16 + fr, k * 32 + fq * 8))
#define MMA(ai, bj, At, Bt_) do { __builtin_amdgcn_s_setprio(1); \
    for (int m = 0; m < 4; ++m) for (int n = 0; n < 2; ++n) for (int k = 0; k < 2; ++k) \
      acc[ai][bj][m][n] = __builtin_amdgcn_mfma_f32_16x16x32_bf16(Bt_[n][k], At[m][k], acc[ai][bj][m][n], 0, 0, 0); \
    __builtin_amdgcn_s_setprio(0); } while (0)
#define WAIT_V(n) asm volatile("s_waitcnt vmcnt(" #n ")" ::: "memory")
#define WAIT_L(n) asm volatile("s_waitcnt lgkmcnt(" #n ")" ::: "memory")
#define BAR __builtin_amdgcn_s_barrier()
#define SCHED __builtin_amdgcn_sched_barrier(0)
    int tzz = TIDX; asm volatile("" : "+v"(tzz));
    const int wid = tzz >> 6, lane = tzz & 63, wr = wid >> 2, wc = wid & 3, fr = lane & 15, fq = lane >> 4;
    unsigned so0, so1;
    { int r0, c0, r1, c1; stage_rc(tzz * 16, r0, c0); stage_rc(tzz * 16 + 8192, r1, c1); so0 = (unsigned)(r0 * K + c0); so1 = (unsigned)(r1 * K + c1); }
    f32x4 acc[2][2][4][2];
    int zsrc = 0; asm volatile("" : "+s"(zsrc));
    const float zf0 = __int_as_float(zsrc);
#pragma unroll
    for (int i0 = 0; i0 < 2; ++i0)
#pragma unroll
        for (int i1 = 0; i1 < 2; ++i1)
#pragma unroll
            for (int i2 = 0; i2 < 4; ++i2)
#pragma unroll
                for (int i3 = 0; i3 < 2; ++i3)
#pragma unroll
                    for (int c = 0; c < 4; ++c) acc[i0][i1][i2][i3][c] = zf0;
    bf16x8 At[4][2], B0[2][2], B1[2][2];
    const int nt = K / BK;
    STAGE(SB(0, 0), Bt, bcol, 0); STAGE(SA(0, 0), A, brow, 0);
    STAGE(SB(0, 1), Bt, bcol + HALF, 0); STAGE(SA(0, 1), A, brow + HALF, 0);
    if (wr == 1) BAR;
    WAIT_V(4); BAR;
    STAGE(SB(1, 0), Bt, bcol, 1); STAGE(SA(1, 0), A, brow, 1); STAGE(SB(1, 1), Bt, bcol + HALF, 1);
    WAIT_V(6); BAR;
    for (int t = 0; t < nt - 2; t += 2) {
        LDB(B0, 0, 0); SCHED; LDA(At, 0, 0); STAGE(SA(1, 1), A, brow + HALF, t + 1);
        WAIT_L(8); BAR; WAIT_L(0); MMA(0, 0, At, B0); BAR; SCHED;
        LDB(B1, 0, 1); STAGE(SB(0, 0), Bt, bcol, t + 2);
        BAR; WAIT_L(0); MMA(0, 1, At, B1); BAR;
        LDA(At, 0, 1); STAGE(SA(0, 0), A, brow, t + 2);
        BAR; WAIT_L(0); MMA(1, 0, At, B0); BAR; SCHED;
        STAGE(SB(0, 1), Bt, bcol + HALF, t + 2);
        WAIT_V(6); BAR; MMA(1, 1, At, B1); BAR;
        LDB(B0, 1, 0); SCHED; LDA(At, 1, 0); STAGE(SA(0, 1), A, brow + HALF, t + 2);
        WAIT_L(8); BAR; WAIT_L(0); MMA(0, 0, At, B0); BAR; SCHED;
        LDB(B1, 1, 1); STAGE(SB(1, 0), Bt, bcol, t + 3);
        BAR; WAIT_L(0); MMA(0, 1, At, B1); BAR;
        LDA(At, 1, 1); STAGE(SA(1, 0), A, brow, t + 3);
        BAR; WAIT_L(0); MMA(1, 0, At, B0); BAR; SCHED;
        STAGE(SB(1, 1), Bt, bcol + HALF, t + 3);
        WAIT_V(6); BAR; MMA(1, 1, At, B1); BAR;
    }
    { LDB(B0, 0, 0); LDA(At, 0, 0); STAGE(SA(1, 1), A, brow + HALF, nt - 1);
      BAR; WAIT_L(0); MMA(0, 0, At, B0); BAR;
      LDB(B1, 0, 1); BAR; WAIT_L(0); MMA(0, 1, At, B1); BAR;
      LDA(At, 0, 1); WAIT_V(4); BAR; WAIT_L(0); MMA(1, 0, At, B0); MMA(1, 1, At, B1); BAR; }
    { LDB(B0, 1, 0); LDA(At, 1, 0); WAIT_V(2); BAR; WAIT_L(0); MMA(0, 0, At, B0); BAR;
      LDB(B1, 1, 1); WAIT_V(0); BAR; WAIT_L(0); MMA(0, 1, At, B1); BAR;
      LDA(At, 1, 1); BAR; WAIT_L(0); MMA(1, 0, At, B0); MMA(1, 1, At, B1); BAR; }
    if (wr == 0) BAR;
    epilogue<EPI>(acc, brow, bcol, Cf, Cb, ldc, scale, gvec, XNout, ssq_out, ssq_in, (float*)((char*)shm + 131072));
    __syncthreads();
#undef SA
#undef SB
#undef STAGE
#undef LDA
#undef LDB
#undef MMA
}
#if 0
    if (EPI == EPI_SWIGLU) {
        const int cb = (bcol >> 1) + wc * 32 + fr;
        for (int ai = 0; ai < 2; ++ai) for (int m = 0; m < 4; ++m) for (int n = 0; n < 2; ++n) for (int j = 0; j < 4; ++j) {
            const float g = acc[ai][0][m][n][j], u = acc[ai][1][m][n][j];
            Cb[(size_t)(brow + ai * HALF + wr * 64 + m * 16 + fq * 4 + j) * ldc + cb + n * 16] = f2bf(siluf_(g) * u);
        }
    } else {
        for (int ai = 0; ai < 2; ++ai) for (int bj = 0; bj < 2; ++bj) for (int m = 0; m < 4; ++m) for (int n = 0; n < 2; ++n) for (int j = 0; j < 4; ++j) {
            float* p = Cf + (size_t)(brow + ai * HALF + wr * 64 + m * 16 + fq * 4 + j) * ldc + (bcol + bj * HALF + wc * 32 + n * 16 + fr);
            if (EPI == EPI_RESID) *p += scale * acc[ai][bj][m][n][j]; else *p = acc[ai][bj][m][n][j];
        }
    }
#endif

template <int EPI>
__device__ __forceinline__ void gemm_phase(const bf16_t* A, const bf16_t* Bt, int M, int N, int K, bf16_t* shm,
                                           float* Cf, bf16_t* Cb, int ldc, float scale, const float* gvec, bf16_t* XNout, float* ssq_out, const float* ssq_in) {
    const int nM = M / BM, nN = N / BM, nwg = nM * nN;
    for (int L = BIDX; L < nwg; L += GDIM) {
        int wgid = L;
        { int q = nwg / NXCD, r = nwg % NXCD, xcd = wgid % NXCD, off = wgid / NXCD;
          wgid = (xcd < r ? xcd * (q + 1) : r * (q + 1) + (xcd - r) * q) + off; }
        int nig = WGM * nN, gid = wgid / nig, fm = gid * WGM, gsz = min(nM - fm, WGM);
        int pm = fm + ((wgid % nig) % gsz), pn = (wgid % nig) / gsz;
        gemm_unit<EPI>(A, Bt, K, pm * BM, pn * BM, shm, Cf, Cb, ldc, scale, gvec, XNout, ssq_out, ssq_in);
    }
}
}

typedef __attribute__((address_space(1))) unsigned char* gas_ptr;
__device__ __forceinline__ gas_ptr launder_ws(unsigned char* p, unsigned long long off) { asm volatile("" : "+s"(off)); return (gas_ptr)p + off; }
#define WSP(T, off) ((T*)(__attribute__((address_space(1))) T*)(launder_ws(AWS, (off))))

__device__ __forceinline__ bf16x8 pack8(f32x4 x0, f32x4 x1) {
    u32x4 o; o.x = pk2(x0.x, x0.y); o.y = pk2(x0.z, x0.w); o.z = pk2(x1.x, x1.y); o.w = pk2(x1.z, x1.w);
    return __builtin_bit_cast(bf16x8, o);
}
__device__ __forceinline__ float gelu_tanh(float x) {
    const float u = 0.7978845608028654f * (x + 0.044715f * x * x * x);
    const float e = __expf(2.f * u);
    const float th = 1.f - 2.f / (e + 1.f);
    return 0.5f * x * (1.f + th);
}

__device__ __forceinline__ void nsa_prep_token(const Args& a, int t, int lane) {
    const float* Pr = WSP(const float, WS_P) + (size_t)t * INP;
    const int b = t / SEQ, s = t % SEQ;
    float q1[6], q2[6], kc1[2], kc2[2], vc1[2], vc2[2], ks1[2], ks2[2], kw1[2], kw2[2];
#pragma unroll
    for (int h = 0; h < 6; ++h) { q1[h] = ldnt(Pr + (C_NQ + h * 128 + lane)); q2[h] = ldnt(Pr + (C_NQ + h * 128 + 64 + lane)); }
#pragma unroll
    for (int g = 0; g < 2; ++g) {
        kc1[g] = ldnt(Pr + (C_NKC + g * 128 + lane)); kc2[g] = ldnt(Pr + (C_NKC + g * 128 + 64 + lane));
        vc1[g] = ldnt(Pr + (C_NVC + g * 128 + lane)); vc2[g] = ldnt(Pr + (C_NVC + g * 128 + 64 + lane));
        ks1[g] = ldnt(Pr + (C_NKS + g * 128 + lane)); ks2[g] = ldnt(Pr + (C_NKS + g * 128 + 64 + lane));
        kw1[g] = ldnt(Pr + (C_NKW + g * 128 + lane)); kw2[g] = ldnt(Pr + (C_NKW + g * 128 + 64 + lane));
    }
    const float gt = lane < 18 ? ldnt(Pr + (C_NGT + lane)) : 0.f;
    const float inv = exp2f(-(float)lane * 0.20762050593046014f);
    float sn, cs; sincosf((float)s * inv, &sn, &cs);
    bf16_t* Qb = WSP(bf16_t, WS_QB) + (size_t)t * 768;
    const float scale = 0.08838834764831845f * 1.4426950408889634f;
#pragma unroll
    for (int h = 0; h < 6; ++h) {
        Qb[h * 128 + lane] = f2bf((q1[h] * cs - q2[h] * sn) * scale);
        Qb[h * 128 + 64 + lane] = f2bf((q2[h] * cs + q1[h] * sn) * scale);
    }
#pragma unroll
    for (int g = 0; g < 2; ++g) {
        const size_t ro = ((size_t)(b * 2 + g) * SEQ + s) * 128;
        { float* o = WSP(float, WS_KCR) + ro; o[lane] = kc1[g] * cs - kc2[g] * sn; o[64 + lane] = kc2[g] * cs + kc1[g] * sn; }
        { float* o = WSP(float, WS_VCR) + ro; o[lane] = vc1[g]; o[64 + lane] = vc2[g]; }
        { bf16_t* o = WSP(bf16_t, WS_KS) + ro; o[lane] = f2bf(ks1[g] * cs - ks2[g] * sn); o[64 + lane] = f2bf(ks2[g] * cs + ks1[g] * sn); }
        { bf16_t* o = WSP(bf16_t, WS_KW) + ro; o[lane] = f2bf(kw1[g] * cs - kw2[g] * sn); o[64 + lane] = f2bf(kw2[g] * cs + kw1[g] * sn); }
    }
    if (lane < 18) WSP(float, WS_GT)[(size_t)t * 32 + lane] = sigmoidf_(gt);
}

__device__ __forceinline__ void vtrans_item(const Args& a, int it, unsigned char* lds) {
    const int which = it & 1, tile = (it >> 1) & 63, bg = it >> 7, b = bg >> 1, g = bg & 1;
    const int col = (which ? C_NVW : C_NVS) + g * 128;
    const float* Pp = WSP(const float, WS_P) + (size_t)(b * SEQ + tile * 64) * INP + col;
    float* scr = (float*)lds;
    const int tid = TIDX;
    lds_barrier();
#pragma unroll
    for (int i = 0; i < 16; ++i) { const int idx = i * 512 + tid, tok = idx >> 7, d = idx & 127; scr[d * 65 + tok] = ldnt(Pp + (size_t)tok * INP + d); }
    lds_barrier();
    const int d = tid >> 2, seg = tid & 3;
    const float* s = scr + d * 65 + seg * 16;
    u32x4 o0, o1;
    o0.x = pk2(s[0], s[1]); o0.y = pk2(s[2], s[3]); o0.z = pk2(s[4], s[5]); o0.w = pk2(s[6], s[7]);
    o1.x = pk2(s[8], s[9]); o1.y = pk2(s[10], s[11]); o1.z = pk2(s[12], s[13]); o1.w = pk2(s[14], s[15]);
    bf16_t* dst = WSP(bf16_t, which ? WS_VWT : WS_VST) + ((size_t)bg * 128 + d) * SEQ + tile * 64 + seg * 16;
    *(u32x4*)dst = o0; *(u32x4*)(dst + 8) = o1;
}

__device__ __forceinline__ void gdn_chunk(const Args& a, int l, int ci, unsigned char* lds) {
    const int bh = ci >> 6, n = ci & 63, b = bh / 5, h = bh % 5, tb = b * SEQ + n * 64, s0 = n * 64;
    float* qf = (float*)lds; float* kf = qf + 64 * 128; float* vf = kf + 64 * 128;
    bf16_t* qb = (bf16_t*)(vf + 64 * 128); bf16_t* kb = qb + 64 * 136;
    float* gcs = (float*)(kb + 64 * 136); float* bts = gcs + 64; float* rq = bts + 64; float* rk = rq + 64;
    float* Am = qf;
    const int tid = TIDX, w = tid >> 6, lane = tid & 63, fr = lane & 15, fq = lane >> 4;
    const float* P = WSP(const float, WS_P);
    lds_barrier();
    if (w == 0) {
        const int t = tb + lane;
        const float av = ldnt(P + ((size_t)t * INP + C_GA + h)) + AIN(16)[l * 5 + h];
        const float ev = __expf(av);
        const float sp = av > 20.f ? av : (ev < 0.0625f ? ev * (1.f - ev * (0.5f - ev * (0.33333334f - 0.25f * ev))) : __logf(1.f + ev));
        float g = -__expf(AIN(15)[l * 5 + h]) * sp;
#pragma unroll
        for (int o = 1; o < 64; o <<= 1) { const float x = __shfl_up(g, o); if (lane >= o) g += x; }
        gcs[lane] = g;
        bts[lane] = sigmoidf_(ldnt(P + ((size_t)t * INP + C_GB + h)));
    }
    const int d = tid & 127, cg = tid >> 7;
    {
        const float* cw = AIN(14) + (size_t)l * 4 * 1920;
#pragma unroll
        for (int which = 0; which < 3; ++which) {
            const int col = (which == 0 ? C_GQ : which == 1 ? C_GK : C_GV) + h * 128 + d, cc = which * 640 + h * 128 + d;
            const float w0 = cw[cc], w1 = cw[1920 + cc], w2 = cw[2 * 1920 + cc], w3 = cw[3 * 1920 + cc];
            float* dst = which == 0 ? qf : which == 1 ? kf : vf;
            const int sb = s0 + cg * 16;
            float xm3 = sb >= 3 ? ldnt(P + ((size_t)(tb + cg * 16 - 3) * INP + col)) : 0.f;
            float xm2 = sb >= 2 ? ldnt(P + ((size_t)(tb + cg * 16 - 2) * INP + col)) : 0.f;
            float xm1 = sb >= 1 ? ldnt(P + ((size_t)(tb + cg * 16 - 1) * INP + col)) : 0.f;
#pragma unroll
            for (int i = 0; i < 16; ++i) {
                const float x = ldnt(P + ((size_t)(tb + cg * 16 + i) * INP + col));
                const float y = w0 * xm3 + w1 * xm2 + w2 * xm1 + w3 * x;
                dst[(cg * 16 + i) * 128 + d] = siluf_(y);
                xm3 = xm2; xm2 = xm1; xm1 = x;
            }
        }
    }
    lds_barrier();
#pragma unroll
    for (int rr = 0; rr < 8; ++rr) {
        const int c = w * 8 + rr;
        const float q0 = qf[c * 128 + lane], q1 = qf[c * 128 + 64 + lane], k0 = kf[c * 128 + lane], k1 = kf[c * 128 + 64 + lane];
        const float sq = wave_sum(q0 * q0 + q1 * q1), sk = wave_sum(k0 * k0 + k1 * k1);
        if (lane == 0) { rq[c] = rsqrtf(sq + 1e-6f) * 0.08838834764831845f; rk[c] = rsqrtf(sk + 1e-6f); }
    }
    lds_barrier();
    {
        const float glast = gcs[63];
        unsigned ktv[8];
#pragma unroll
        for (int i = 0; i < 16; ++i) {
            const int c = cg * 16 + i;
            const float qh = qf[c * 128 + d] * rq[c], kh = kf[c * 128 + d] * rk[c], eg = __expf(gcs[c]);
            qb[c * 136 + d] = f2bf(qh); kb[c * 136 + d] = f2bf(kh);
            WSP(bf16_t, WS_GQD)[((size_t)ci * 64 + c) * 128 + d] = f2bf(qh * eg);
            const unsigned short kt = f2bf(kh * __expf(glast - gcs[c]));
            if (i & 1) ktv[i >> 1] |= ((unsigned)kt) << 16; else ktv[i >> 1] = kt;
            kf[c * 128 + d] = kh * bts[c] * eg;
            vf[c * 128 + d] *= bts[c];
        }
        u32x4* dst = (u32x4*)(WSP(bf16_t, WS_GKT) + ((size_t)ci * 128 + d) * 64 + cg * 16);
        dst[0] = (u32x4){ktv[0], ktv[1], ktv[2], ktv[3]}; dst[1] = (u32x4){ktv[4], ktv[5], ktv[6], ktv[7]};
        if (tid == 0) WSP(float, WS_GLAST)[ci] = __expf(glast);
    }
    lds_barrier();
    {
        const int mt = w & 3;
        const bf16_t* Ab = (w < 4) ? kb : qb;
#pragma unroll
        for (int ntile = 0; ntile < 4; ++ntile) {
            f32x4 acc = zero4();
            if (ntile <= mt) {
#pragma unroll
                for (int ks = 0; ks < 4; ++ks) {
                    const bf16x8 av = *(const bf16x8*)(Ab + (mt * 16 + fr) * 136 + ks * 32 + fq * 8);
                    const bf16x8 bv = *(const bf16x8*)(kb + (ntile * 16 + fr) * 136 + ks * 32 + fq * 8);
                    acc = mfma16(av, bv, acc);
                }
            }
#pragma unroll
            for (int j = 0; j < 4; ++j) {
                const int i_ = mt * 16 + 4 * fq + j, j_ = ntile * 16 + fr;
                const float dec = __expf(fminf(gcs[i_] - gcs[j_], 0.f));
                if (w < 4) Am[j_ * 68 + i_] = (j_ < i_) ? bts[i_] * acc[j] * dec : 0.f;
                else WSP(bf16_t, WS_GAT)[((size_t)ci * 64 + i_) * 64 + j_] = f2bf((j_ <= i_) ? acc[j] * dec : 0.f);
            }
        }
    }
    lds_barrier();
    if (tid < 256) {
        const float* rhs = tid < 128 ? vf + tid : kf + (tid - 128);
        float x[64];
#pragma unroll
        for (int i = 0; i < 64; ++i) x[i] = rhs[i * 128];
#pragma unroll
        for (int j = 0; j < 63; ++j) {
            const float xj = x[j];
#pragma unroll
            for (int i4 = (j + 1) / 4; i4 < 16; ++i4) {
                const f32x4 a4 = *(const f32x4*)(Am + j * 68 + 4 * i4);
                if (4 * i4 + 0 > j) x[4 * i4 + 0] -= a4.x * xj;
                if (4 * i4 + 1 > j) x[4 * i4 + 1] -= a4.y * xj;
                if (4 * i4 + 2 > j) x[4 * i4 + 2] -= a4.z * xj;
                if (4 * i4 + 3 > j) x[4 * i4 + 3] -= a4.w * xj;
            }
        }
        if (tid < 128) {
            float* U = WSP(float, WS_GU) + (size_t)ci * 64 * 128 + tid;
#pragma unroll
            for (int i = 0; i < 64; ++i) U[i * 128] = x[i];
        } else {
            bf16_t* Wn = WSP(bf16_t, WS_GWN) + (size_t)ci * 64 * 128 + (tid - 128);
#pragma unroll
            for (int i = 0; i < 64; ++i) Wn[i * 128] = f2bf(-x[i]);
        }
    }
}

__device__ __forceinline__ void hgrn_chunk(const Args& a, int l, int ci, unsigned char* lds) {
    const int bh = ci >> 6, n = ci & 63, b = bh / 5, h = bh % 5, tb = b * SEQ + n * 64;
    bf16_t* qb = (bf16_t*)lds; bf16_t* kb = qb + 64 * 136; float* tot = (float*)(kb + 64 * 136);
    const int tid = TIDX, w = tid >> 6, lane = tid & 63, fr = lane & 15, fq = lane >> 4;
    const int d = tid & 127, cg = tid >> 7;
    const float* P = WSP(const float, WS_P);
    const float lbv = WSP(const float, WS_LB)[l * 640 + h * 128 + d];
    float bl[16], kk[16]; float run = 0.f;
    lds_barrier();
#pragma unroll
    for (int i = 0; i < 16; ++i) {
        const float hf = ldnt(P + (size_t)(tb + cg * 16 + i) * INP + C_HF + h * 128 + d);
        const float f = lbv + (1.f - lbv) * sigmoidf_(hf);
        run += __logf(fmaxf(f, 1e-6f)); bl[i] = run; kk[i] = 1.f - f;
    }
    tot[cg * 128 + d] = run;
    lds_barrier();
    {
        const float t0 = tot[d], t1 = tot[128 + d], t2 = tot[256 + d], t3 = tot[384 + d];
        const float off = (cg > 0 ? t0 : 0.f) + (cg > 1 ? t1 : 0.f) + (cg > 2 ? t2 : 0.f);
        const float blast = t0 + t1 + t2 + t3, bref = t0 + t1;
        unsigned ktv[8], vtv[8];
        float qv[16], hv[16];
#pragma unroll
        for (int i = 0; i < 16; ++i) { const size_t pr = (size_t)(tb + cg * 16 + i) * INP; qv[i] = ldnt(P + pr + C_HQ + h * 128 + d); hv[i] = ldnt(P + pr + C_HI + h * 128 + d); }
#pragma unroll
        for (int i = 0; i < 16; ++i) {
            const int c = cg * 16 + i;
            const float bc = bl[i] + off, q = qv[i];
            qb[c * 136 + d] = f2bf(q * __expf(bc - bref));
            kb[c * 136 + d] = f2bf(kk[i] * __expf(bref - bc));
            WSP(bf16_t, WS_HQE)[((size_t)ci * 64 + c) * 128 + d] = f2bf(q * __expf(bc));
            const unsigned short kt = f2bf(kk[i] * __expf(blast - bc)), vt = f2bf(hv[i]);
            if (i & 1) { ktv[i >> 1] |= ((unsigned)kt) << 16; vtv[i >> 1] |= ((unsigned)vt) << 16; } else { ktv[i >> 1] = kt; vtv[i >> 1] = vt; }
        }
        u32x4* dk = (u32x4*)(WSP(bf16_t, WS_HKT) + ((size_t)ci * 128 + d) * 64 + cg * 16);
        dk[0] = (u32x4){ktv[0], ktv[1], ktv[2], ktv[3]}; dk[1] = (u32x4){ktv[4], ktv[5], ktv[6], ktv[7]};
        u32x4* dv = (u32x4*)(WSP(bf16_t, WS_HVT) + ((size_t)ci * 128 + d) * 64 + cg * 16);
        dv[0] = (u32x4){vtv[0], vtv[1], vtv[2], vtv[3]}; dv[1] = (u32x4){vtv[4], vtv[5], vtv[6], vtv[7]};
        if (cg == 0) WSP(float, WS_HDL)[(size_t)ci * 128 + d] = __expf(blast);
    }
    lds_barrier();
    {
        const int mt = w >> 1;
#pragma unroll
        for (int nn = 0; nn < 2; ++nn) {
            const int ntile = (w & 1) * 2 + nn;
            f32x4 acc = zero4();
            if (ntile <= mt) {
#pragma unroll
                for (int ks = 0; ks < 4; ++ks) {
                    const bf16x8 av = *(const bf16x8*)(qb + (mt * 16 + fr) * 136 + ks * 32 + fq * 8);
                    const bf16x8 bv = *(const bf16x8*)(kb + (ntile * 16 + fr) * 136 + ks * 32 + fq * 8);
                    acc = mfma16(av, bv, acc);
                }
            }
#pragma unroll
            for (int j = 0; j < 4; ++j) {
                const int i_ = mt * 16 + 4 * fq + j, j_ = ntile * 16 + fr;
                WSP(bf16_t, WS_HAM)[((size_t)ci * 64 + i_) * 64 + j_] = f2bf((j_ <= i_) ? acc[j] : 0.f);
            }
        }
    }
}

struct ScanRegs { bf16x8 a10, a11, a12, a13, at0, at1, kt0, kt1, vt0, vt1; f32x4 u; f32x4 dl; };
template <int TYPE>
__device__ __forceinline__ void scan_load(ScanRegs& R, const Args& a, size_t ci, int w, int mt, int fr, int fq, int e0) {
    if (TYPE == 0) {
        {
            const float* U = WSP(const float, WS_GU) + (ci * 64 + mt * 16 + 4 * fq) * 128 + e0 + fr;
            R.u = (f32x4){U[0], U[128], U[256], U[384]};
            const bf16_t* Wn = WSP(const bf16_t, (w < 4) ? WS_GWN : WS_GQD) + (ci * 64 + mt * 16 + fr) * 128 + fq * 8;
            R.a10 = *(const bf16x8*)(Wn); R.a11 = *(const bf16x8*)(Wn + 32); R.a12 = *(const bf16x8*)(Wn + 64); R.a13 = *(const bf16x8*)(Wn + 96);
            const bf16_t* At = WSP(const bf16_t, WS_GAT) + (ci * 64 + mt * 16 + fr) * 64 + fq * 8;
            R.at0 = *(const bf16x8*)(At); R.at1 = *(const bf16x8*)(At + 32);
        }
        const float last = WSP(const float, WS_GLAST)[ci];
        R.dl = (f32x4){last, last, last, last};
        const bf16_t* Kt = WSP(const bf16_t, WS_GKT) + (ci * 128 + 16 * w + fr) * 64 + fq * 8;
        R.kt0 = *(const bf16x8*)(Kt); R.kt1 = *(const bf16x8*)(Kt + 32);
    } else {
        const bf16_t* Vt = WSP(const bf16_t, WS_HVT) + (ci * 128 + e0 + fr) * 64 + fq * 8;
        R.vt0 = *(const bf16x8*)(Vt); R.vt1 = *(const bf16x8*)(Vt + 32);
        if (w >= 4) {
            const bf16_t* Qd = WSP(const bf16_t, WS_HQE) + (ci * 64 + mt * 16 + fr) * 128 + fq * 8;
            R.a10 = *(const bf16x8*)(Qd); R.a11 = *(const bf16x8*)(Qd + 32); R.a12 = *(const bf16x8*)(Qd + 64); R.a13 = *(const bf16x8*)(Qd + 96);
            const bf16_t* At = WSP(const bf16_t, WS_HAM) + (ci * 64 + mt * 16 + fr) * 64 + fq * 8;
            R.at0 = *(const bf16x8*)(At); R.at1 = *(const bf16x8*)(At + 32);
        }
        R.dl = *(const f32x4*)(WSP(const float, WS_HDL) + ci * 128 + 16 * w + 4 * fq);
        const bf16_t* Kt = WSP(const bf16_t, WS_HKT) + (ci * 128 + 16 * w + fr) * 64 + fq * 8;
        R.kt0 = *(const bf16x8*)(Kt); R.kt1 = *(const bf16x8*)(Kt + 32);
    }
}
template <int TYPE>
__device__ __forceinline__ void scan_step(const ScanRegs& R, const Args& a, f32x4& Sacc, bf16_t* St, bf16_t* Vn, int w, int mt, int fr, int fq, float* Orow) {
    f32x4 oacc = zero4();
    bf16x8 bv0, bv1;
    if (TYPE == 0) {
        if (w < 4) {
            f32x4 acc = R.u;
            { const bf16_t* sp = St + fr * 136 + fq * 8;
              acc = mfma16(R.a10, *(const bf16x8*)(sp), acc); acc = mfma16(R.a11, *(const bf16x8*)(sp + 32), acc);
              acc = mfma16(R.a12, *(const bf16x8*)(sp + 64), acc); acc = mfma16(R.a13, *(const bf16x8*)(sp + 96), acc); }
            u32x2 o; o.x = pk2(acc[0], acc[1]); o.y = pk2(acc[2], acc[3]);
            *(u32x2*)(Vn + fr * 72 + mt * 16 + 4 * fq) = o;
        } else {
            { const bf16_t* sp = St + fr * 136 + fq * 8;
              oacc = mfma16(R.a10, *(const bf16x8*)(sp), oacc); oacc = mfma16(R.a11, *(const bf16x8*)(sp + 32), oacc);
              oacc = mfma16(R.a12, *(const bf16x8*)(sp + 64), oacc); oacc = mfma16(R.a13, *(const bf16x8*)(sp + 96), oacc); }
        }
        lds_barrier();
        bv0 = *(const bf16x8*)(Vn + fr * 72 + fq * 8); bv1 = *(const bf16x8*)(Vn + fr * 72 + 32 + fq * 8);
    } else {
        bv0 = R.vt0; bv1 = R.vt1;
        if (w >= 4) {
            { const bf16_t* sp = St + fr * 136 + fq * 8;
              oacc = mfma16(R.a10, *(const bf16x8*)(sp), oacc); oacc = mfma16(R.a11, *(const bf16x8*)(sp + 32), oacc);
              oacc = mfma16(R.a12, *(const bf16x8*)(sp + 64), oacc); oacc = mfma16(R.a13, *(const bf16x8*)(sp + 96), oacc); }
        }
        lds_barrier();
    }
    if (w >= 4) {
        oacc = mfma16(R.at0, bv0, oacc);
        oacc = mfma16(R.at1, bv1, oacc);
#pragma unroll
        for (int j = 0; j < 4; ++j) Orow[(size_t)j * 640] = oacc[j];
    }
    Sacc = Sacc * R.dl;
    Sacc = mfma16(R.kt0, bv0, Sacc);
    Sacc = mfma16(R.kt1, bv1, Sacc);
    u32x2 o; o.x = pk2(Sacc[0], Sacc[1]); o.y = pk2(Sacc[2], Sacc[3]);
    *(u32x2*)(St + fr * 136 + 16 * w + 4 * fq) = o;
    lds_barrier();
}
template <int TYPE>
__device__ __forceinline__ void scan_task(const Args& a, int task, unsigned char* lds) {
    const int bh = task >> 3, es = task & 7, e0 = es * 16, b = bh / 5, h = bh % 5;
    const int tid = TIDX, w = __builtin_amdgcn_readfirstlane(tid >> 6), lane = tid & 63, fr = lane & 15, fq = lane >> 4;
    bf16_t* St = (bf16_t*)lds;
    bf16_t* Vn = St + 16 * 136;
    __syncthreads();
    for (int i = tid; i < 16 * 136; i += 512) St[i] = 0;
    f32x4 Sacc = zero4();
    const int mt = w & 3;
    float* Obase = WSP(float, TYPE == 0 ? WS_OG : WS_OH) + ((size_t)(b * SEQ + mt * 16 + 4 * fq)) * 640 + h * 128 + e0 + fr;
    ScanRegs R0, R1;
    scan_load<TYPE>(R0, a, (size_t)bh * 64, w, mt, fr, fq, e0);
    __syncthreads();
    for (int n = 0; n < NCH; n += 2) {
        scan_load<TYPE>(R1, a, (size_t)bh * 64 + n + 1, w, mt, fr, fq, e0);
        scan_step<TYPE>(R0, a, Sacc, St, Vn, w, mt, fr, fq, Obase + (size_t)n * 64 * 640);
        scan_load<TYPE>(R0, a, (size_t)bh * 64 + (n + 2 < NCH ? n + 2 : NCH - 1), w, mt, fr, fq, e0);
        scan_step<TYPE>(R1, a, Sacc, St, Vn, w, mt, fr, fq, Obase + (size_t)(n + 1) * 64 * 640);
    }
}

__device__ __forceinline__ void compress_item(const Args& a, int l, int it, unsigned char* lds, unsigned* cmp_done) {
    const int which = it >> 6, bg = (it >> 4) & 3, rg = it & 15;
    const int tid = TIDX, w = tid >> 6, lane = tid & 63, fr = lane & 15, fq = lane >> 4;
    const float* X = WSP(const float, which ? WS_VCR : WS_KCR) + (size_t)bg * SEQ * 128;
    const float* pe = sel_ptr(which != 0, AIN(9), AIN(8)) + (size_t)l * 32 * 128;
    const bf16_t* W1t = WSP(const bf16_t, which ? WS_CV1 : WS_CK1);
    const bf16_t* W2t = WSP(const bf16_t, which ? WS_CV2 : WS_CK2);
    bf16_t* Hs = (bf16_t*)lds;
    float* Part = (float*)(lds + 8192);
    const int nc = rg * 16 + fr, ncl = nc < 255 ? nc : 254;
    const float* arow = X + (size_t)ncl * 16 * 128 + w * 512 + fq * 8;
    const bf16_t* brow = W1t + (size_t)fr * 4096 + w * 512 + fq * 8;
    const float* per = pe + w * 512 + fq * 8;
    f32x4 acc[8];
#pragma unroll
    for (int nt = 0; nt < 8; ++nt) acc[nt] = zero4();
    __syncthreads();
#pragma unroll 2
    for (int kk = 0; kk < 16; ++kk) {
        const f32x4 x0 = *(const f32x4*)(arow + kk * 32), x1 = *(const f32x4*)(arow + kk * 32 + 4);
        const f32x4 p0 = *(const f32x4*)(per + kk * 32), p1 = *(const f32x4*)(per + kk * 32 + 4);
        bf16x8 bfr[8];
#pragma unroll
        for (int nt = 0; nt < 8; ++nt) bfr[nt] = *(const bf16x8*)(brow + (size_t)nt * 16 * 4096 + kk * 32);
        const bf16x8 av = pack8(x0 + p0, x1 + p1);
#pragma unroll
        for (int nt = 0; nt < 8; ++nt) acc[nt] = mfma16(av, bfr[nt], acc[nt]);
    }
#pragma unroll
    for (int nt = 0; nt < 8; ++nt)
#pragma unroll
        for (int j = 0; j < 4; ++j) Part[(w * 16 + fq * 4 + j) * 132 + nt * 16 + fr] = acc[nt][j];
    __syncthreads();
    {
        const int row = tid >> 5, c4 = (tid & 31) * 4;
        f32x4 sum = *(const f32x4*)(Part + row * 132 + c4);
#pragma unroll
        for (int ww = 1; ww < 8; ++ww) sum = sum + *(const f32x4*)(Part + (ww * 16 + row) * 132 + c4);
        u32x2 o; o.x = pk2(gelu_tanh(sum.x), gelu_tanh(sum.y)); o.y = pk2(gelu_tanh(sum.z), gelu_tanh(sum.w));
        *(u32x2*)(Hs + row * 136 + c4) = o;
    }
    __syncthreads();
    f32x4 acc2 = zero4();
#pragma unroll
    for (int ks = 0; ks < 4; ++ks)
        acc2 = mfma16(*(const bf16x8*)(Hs + fr * 136 + ks * 32 + fq * 8), *(const bf16x8*)(W2t + (size_t)(w * 16 + fr) * 128 + ks * 32 + fq * 8), acc2);
    const int dcol = w * 16 + fr;
    if (which == 0) {
#pragma unroll
        for (int j = 0; j < 4; ++j) { const int r = rg * 16 + fq * 4 + j; WSP(bf16_t, WS_KCB)[((size_t)bg * 256 + r) * 128 + dcol] = r < 255 ? f2bf(acc2[j]) : (bf16_t)0; }
    } else {
        const int r0 = rg * 16 + fq * 4;
        u32x2 o; o.x = pk2(acc2[0], acc2[1]); o.y = pk2(acc2[2], (r0 + 3 < 255) ? acc2[3] : 0.f);
        *(u32x2*)(WSP(bf16_t, WS_VCT) + ((size_t)bg * 128 + dcol) * 256 + r0) = o;
    }
    asm volatile("s_waitcnt vmcnt(0)" ::: "memory");
    __syncthreads();
    if (TIDX == 0) { __builtin_amdgcn_fence(__ATOMIC_RELEASE, "agent"); asm volatile("s_waitcnt vmcnt(0)" ::: "memory"); xb_add(cmp_done, 1u); }
}

constexpr int AT_K = 0;
constexpr int AT_V = 2 * 64 * 136 * 2;
constexpr int AT_PW = AT_V + 2 * 128 * 72 * 2;
constexpr int AT_MASK = AT_PW + 8 * 16 * 72 * 2;
constexpr int AT_WM = AT_MASK + 128 * 8;
constexpr int AT_PC = 0;
static_assert(8 * 16 * 264 * 2 <= AT_PW, "PC alias");
constexpr int AT_IMP = AT_WM + 64;
constexpr int AT_END = AT_IMP + 8 * 16 * 64 * 4;
static_assert(AT_END <= LDS_BYTES, "attention LDS");

__device__ __forceinline__ float rmax16(float v) {
    v = fmaxf(v, __shfl_xor(v, 1)); v = fmaxf(v, __shfl_xor(v, 2)); v = fmaxf(v, __shfl_xor(v, 4)); v = fmaxf(v, __shfl_xor(v, 8));
    return v;
}
__device__ __forceinline__ float rsum16(float v) {
    v += __shfl_xor(v, 1); v += __shfl_xor(v, 2); v += __shfl_xor(v, 4); v += __shfl_xor(v, 8);
    return v;
}

struct TileRegs { u32x4 k[2], v[2]; };
__device__ __forceinline__ void tile_load(TileRegs& r, const bf16_t* Kg, const bf16_t* Vtg, int kb) {
    const int tid = TIDX;
#pragma unroll
    for (int i = 0; i < 2; ++i) {
        const int idx = tid + i * 512;
        r.k[i] = *(const u32x4*)(Kg + ((size_t)kb * 64 + (idx >> 4)) * 128 + (idx & 15) * 8);
        r.v[i] = *(const u32x4*)(Vtg + (size_t)(idx >> 3) * SEQ + kb * 64 + (idx & 7) * 8);
    }
}
__device__ __forceinline__ void tile_store(const TileRegs& r, bf16_t* Ks, bf16_t* Vs) {
    const int tid = TIDX;
#pragma unroll
    for (int i = 0; i < 2; ++i) {
        const int idx = tid + i * 512;
        *(u32x4*)(Ks + (idx >> 4) * 136 + (idx & 15) * 8) = r.k[i];
        const int c = idx & 7, s0 = (c >> 2) * 32 + ((2 * c) & 3) * 8 + ((c >> 1) & 1) * 4;
        bf16_t* vr = Vs + (idx >> 3) * 72;
        *(u32x2*)(vr + s0) = (u32x2){r.v[i].x, r.v[i].y};
        *(u32x2*)(vr + s0 + 8) = (u32x2){r.v[i].z, r.v[i].w};
    }
}

constexpr int RING_SLOT = 32768, RING_V = 16384;
__device__ __forceinline__ void tile_dma(unsigned char* lds, int slot, const bf16_t* Kg, const bf16_t* Vtg, int kb, int tid) {
    unsigned char* kd = lds + slot * RING_SLOT; unsigned char* vd = kd + RING_V;
#pragma unroll
    for (int i = 0; i < 2; ++i) {
        const int q = i * 512 + tid;
        { const int rs = q >> 4, pos = q & 15, c = pos ^ (rs & 15), nt = rs >> 4, r16 = rs & 15;
          const int keyl = 32 * (nt >> 1) + 8 * (r16 >> 2) + 4 * (nt & 1) + (r16 & 3);
          __builtin_amdgcn_global_load_lds((const unsigned*)(Kg + ((size_t)kb * 64 + keyl) * 128 + c * 8),
                                           (__attribute__((address_space(3))) unsigned*)(kd + q * 16), 16, 0, 0); }
        { const int d = q >> 3, pos = q & 7, c = pos ^ ((d >> 1) & 7);
          __builtin_amdgcn_global_load_lds((const unsigned*)(Vtg + (size_t)d * SEQ + kb * 64 + c * 8),
                                           (__attribute__((address_space(3))) unsigned*)(vd + q * 16), 16, 0, 0); }
    }
}
template <int MODE>
__device__ __forceinline__ void attn_compute(const bf16x8 (&qf)[4], const unsigned char* Ks, const unsigned char* Vs, int kb, int tok,
                                             unsigned long long msk, f32x4 (&O)[8], float& mrow, float& lrow) {
    const int lane = TIDX & 63, fr = lane & 15, fq = lane >> 4;
    if (MODE == 1) {
        if (__builtin_amdgcn_ballot_w64(((msk >> kb) & 1ull) != 0ull) == 0ull) return;
    }
    f32x4 S[4];
    {
        bf16x8 kf[16];
#pragma unroll
        for (int i = 0; i < 16; ++i) kf[i] = *(const bf16x8*)(Ks + ((i >> 2) * 16 + fr) * 256 + ((((i & 3) * 4 + fq) ^ fr) * 16));
        __builtin_amdgcn_sched_barrier(0);
#pragma unroll
        for (int nt = 0; nt < 4; ++nt) {
            S[nt] = zero4();
#pragma unroll
            for (int ks = 0; ks < 4; ++ks) S[nt] = mfma16(kf[nt * 4 + ks], qf[ks], S[nt]);
        }
    }
    bf16x8 vf[16];
#pragma unroll
    for (int i = 0; i < 16; ++i) vf[i] = *(const bf16x8*)(Vs + ((i & 7) * 16 + fr) * 128 + ((((i >> 3) * 4 + fq) ^ ((fr >> 1) & 7)) * 16));
    const bool rowok = (MODE == 0) ? true : (((msk >> kb) & 1ull) != 0ull);
    const int key0 = kb * 64 + 8 * fq;
    const int tb = __builtin_amdgcn_readfirstlane(tok - fr);
    const bool interior = (kb * 64 + 63 <= tb) && (MODE == 1 || kb * 64 > tb + 15 - 512);
    float mx = -1e30f;
    if (interior) {
#pragma unroll
        for (int nt = 0; nt < 4; ++nt)
#pragma unroll
            for (int c = 0; c < 4; ++c) {
                if (MODE == 1) S[nt][c] = rowok ? S[nt][c] : -1e30f;
                mx = fmaxf(mx, S[nt][c]);
            }
    } else {
#pragma unroll
        for (int nt = 0; nt < 4; ++nt)
#pragma unroll
            for (int c = 0; c < 4; ++c) {
                const int key = key0 + 32 * (nt >> 1) + 4 * (nt & 1) + c;
                const bool ok = rowok && (key <= tok) && (MODE == 1 || key > tok - 512);
                S[nt][c] = ok ? S[nt][c] : -1e30f;
                mx = fmaxf(mx, S[nt][c]);
            }
    }
    mx = fmaxf(mx, __shfl_xor(mx, 16)); mx = fmaxf(mx, __shfl_xor(mx, 32));
    const float mnew = fmaxf(mrow, mx), alpha = __builtin_amdgcn_exp2f(mrow - mnew);
    mrow = mnew;
    float ps = 0.f;
    if (MODE == 0 && interior) {
#pragma unroll
        for (int nt = 0; nt < 4; ++nt)
#pragma unroll
            for (int c = 0; c < 4; ++c) { const float p = __builtin_amdgcn_exp2f(S[nt][c] - mnew); S[nt][c] = p; ps += p; }
    } else {
#pragma unroll
        for (int nt = 0; nt < 4; ++nt)
#pragma unroll
            for (int c = 0; c < 4; ++c) {
                const float p = (S[nt][c] > -1e29f) ? __builtin_amdgcn_exp2f(S[nt][c] - mnew) : 0.f;
                S[nt][c] = p; ps += p;
            }
    }
    lrow = lrow * alpha + ps;
#pragma unroll
    for (int dt = 0; dt < 8; ++dt) O[dt] = O[dt] * alpha;
#pragma unroll
    for (int kk = 0; kk < 2; ++kk) {
        u32x4 pw; pw.x = pk2(S[2 * kk][0], S[2 * kk][1]); pw.y = pk2(S[2 * kk][2], S[2 * kk][3]);
        pw.z = pk2(S[2 * kk + 1][0], S[2 * kk + 1][1]); pw.w = pk2(S[2 * kk + 1][2], S[2 * kk + 1][3]);
        const bf16x8 pb = __builtin_bit_cast(bf16x8, pw);
#pragma unroll
        for (int dt = 0; dt < 8; ++dt) O[dt] = mfma16(vf[kk * 8 + dt], pb, O[dt]);
    }
}

template <int MODE>
__device__ __forceinline__ void attn_head(const bf16_t* qptr, const bf16_t* Kg, const bf16_t* Vtg, unsigned long long un, int tok,
                                          unsigned long long msk, unsigned char* lds, f32x4 (&O)[8], float& lrow) {
    const int tid = TIDX;
    bf16x8 qf[4];
#pragma unroll
    for (int ks = 0; ks < 4; ++ks) qf[ks] = *(const bf16x8*)(qptr + ks * 32);
    float mrow = -1e30f; lrow = 0.f;
#pragma unroll
    for (int dt = 0; dt < 8; ++dt) O[dt] = zero4();
    const int n = __builtin_popcountll(un);
    unsigned long long remc = un, remp = un;
    int kpre = __builtin_ctzll(remp); remp &= remp - 1;
    lds_barrier();
    tile_dma(lds, 0, Kg, Vtg, kpre, tid);
    if (remp) { kpre = __builtin_ctzll(remp); remp &= remp - 1; }
    tile_dma(lds, 1, Kg, Vtg, kpre, tid);
    int slot = 0;
    for (int i = 0; i < n; ++i) {
        const int kb = __builtin_ctzll(remc); remc &= remc - 1;
        asm volatile("s_waitcnt vmcnt(4)" ::: "memory");
        __builtin_amdgcn_s_barrier();
        asm volatile("" ::: "memory");
        if (remp) { kpre = __builtin_ctzll(remp); remp &= remp - 1; }
        int ps = slot + 2; ps = ps >= 3 ? ps - 3 : ps;
        tile_dma(lds, ps, Kg, Vtg, kpre, tid);
        attn_compute<MODE>(qf, lds + slot * RING_SLOT, lds + slot * RING_SLOT + RING_V, kb, tok, msk, O, mrow, lrow);
        asm volatile("s_waitcnt lgkmcnt(0)" ::: "memory");
        slot = slot == 2 ? 0 : slot + 1;
    }
    asm volatile("s_waitcnt vmcnt(0)" ::: "memory");
    lrow += __shfl_xor(lrow, 16); lrow += __shfl_xor(lrow, 32);
}

__device__ __forceinline__ void load_q(bf16x8 (&qf)[4], const Args& a, int t, int head) {
    const int lane = TIDX & 63, fr = lane & 15, fq = lane >> 4;
    const bf16_t* q = WSP(const bf16_t, WS_QB) + (size_t)(t + fr) * 768 + head * 128 + fq * 8;
#pragma unroll
    for (int ks = 0; ks < 4; ++ks) qf[ks] = *(const bf16x8*)(q + ks * 32);
}

__device__ __forceinline__ void window_item(const Args& a, int it, unsigned char* lds) {
    const int qt = it & 31, bh = it >> 5, b = bh / 6, hd = bh % 6, g = hd / 3, r = hd % 3, bg = b * 2 + g, t0 = qt * 128;
    const int tid = TIDX, w = tid >> 6, lane = tid & 63, fr = lane & 15, fq = lane >> 4;
    const bf16_t* Kg = WSP(const bf16_t, WS_KW) + (size_t)bg * SEQ * 128;
    const bf16_t* Vtg = WSP(const bf16_t, WS_VWT) + (size_t)bg * 128 * SEQ;
    const int tokbase = t0 + 16 * w;
    const bf16_t* qptr = WSP(const bf16_t, WS_QB) + (size_t)(b * SEQ + tokbase + fr) * 768 + hd * 128 + fq * 8;
    f32x4 O[8]; float lrow;
    const int kb_lo = (t0 >> 6) >= 8 ? (t0 >> 6) - 8 : 0, kb_hi = (t0 >> 6) + 1;
    const unsigned long long un = ((kb_hi >= 63) ? ~0ull : ((1ull << (kb_hi + 1)) - 1ull)) & ~((1ull << kb_lo) - 1ull);
    attn_head<0>(qptr, Kg, Vtg, un, tokbase + fr, 0ull, lds, O, lrow);
    const float* GT = WSP(const float, WS_GT);
    float* On = WSP(float, WS_ONSA);
    {
        const int t = b * SEQ + tokbase + fr;
        const float sc = GT[(size_t)t * 32 + g * 9 + r * 3 + 2] / fmaxf(lrow, 1e-30f);
#pragma unroll
        for (int dt = 0; dt < 8; ++dt) *(f32x4*)(On + (size_t)t * 768 + hd * 128 + dt * 16 + 4 * fq) = O[dt] * sc;
    }
}

__device__ __forceinline__ void cmpsel_item(const Args& a, int it, unsigned char* lds, unsigned* cmp_done) {
    const int bg = it & 3, qt = 31 - (it >> 2), b = bg >> 1, g = bg & 1, t0 = qt * 128;
    const int tid = TIDX, w = tid >> 6, lane = tid & 63, fr = lane & 15, fq = lane >> 4;
    const int tokbase = t0 + 16 * w;
    const float* GT = WSP(const float, WS_GT);
    float* On = WSP(float, WS_ONSA);
    float* Oc2 = WSP(float, WS_ONC);
    bf16_t* Pc = (bf16_t*)(lds + AT_PC) + w * 16 * 264;
    float* imps = (float*)(lds + AT_IMP) + w * 16 * 64;
    unsigned long long* maskL = (unsigned long long*)(lds + AT_MASK);
    unsigned long long* wmL = (unsigned long long*)(lds + AT_WM);
    __syncthreads();
    if (TIDX == 0) { unsigned sp = 0; while (xb_ld(cmp_done) < 128u && sp < (1u << 22)) { __builtin_amdgcn_s_sleep(2); ++sp; } }
    __syncthreads();
    __builtin_amdgcn_fence(__ATOMIC_ACQUIRE, "agent");
    asm volatile("s_waitcnt vmcnt(0)" ::: "memory");
    {
        const bf16_t* Kc = WSP(const bf16_t, WS_KCB) + (size_t)bg * 256 * 128;
        const bf16_t* Vc = WSP(const bf16_t, WS_VCT) + (size_t)bg * 128 * 256;
#pragma unroll 1
        for (int r = 0; r < 3; ++r) {
            int lz = lane; asm volatile("" : "+v"(lz));
            const int lane = lz, fr = lz & 15, fq = lz >> 4;
            bf16x8 qf[4];
            { const bf16_t* q = WSP(const bf16_t, WS_QB) + (size_t)(b * SEQ + tokbase + fr) * 768 + (g * 3 + r) * 128 + fq * 8;
#pragma unroll
              for (int ks = 0; ks < 4; ++ks) qf[ks] = *(const bf16x8*)(q + ks * 32); }
            f32x4 S[16];
            const int tmaxw = __builtin_amdgcn_readfirstlane(tokbase) + 15;
#pragma unroll
            for (int g4 = 0; g4 < 4; ++g4) {
#pragma unroll
                for (int n4 = 0; n4 < 4; ++n4) S[g4 * 4 + n4] = zero4();
                if (1024 * g4 + 31 <= tmaxw) {
                    bf16x8 kf[16];
#pragma unroll
                    for (int i = 0; i < 16; ++i) kf[i] = *(const bf16x8*)(Kc + (size_t)((g4 * 4 + (i >> 2)) * 16 + fr) * 128 + (i & 3) * 32 + fq * 8);
#pragma unroll
                    for (int n4 = 0; n4 < 4; ++n4) {
#pragma unroll
                        for (int ks = 0; ks < 4; ++ks) S[g4 * 4 + n4] = mfma16(qf[ks], kf[n4 * 4 + ks], S[g4 * 4 + n4]);
                    }
                }
            }
#pragma unroll
            for (int j = 0; j < 4; ++j) {
                const int tok = tokbase + fq * 4 + j;
                float mx = -1e30f;
#pragma unroll
                for (int nt = 0; nt < 16; ++nt) { const int n = nt * 16 + fr; if (n < 255 && 16 * n + 31 <= tok) mx = fmaxf(mx, S[nt][j]); }
                mx = rmax16(mx);
                float ps = 0.f;
#pragma unroll
                for (int nt = 0; nt < 16; ++nt) { const int n = nt * 16 + fr; const float p = (n < 255 && 16 * n + 31 <= tok) ? __builtin_amdgcn_exp2f(S[nt][j] - mx) : 0.f; S[nt][j] = p; ps += p; }
                ps = rsum16(ps);
                const float inv = 1.f / fmaxf(ps, 1e-30f);
#pragma unroll
                for (int nt = 0; nt < 16; ++nt) { const float p = S[nt][j] * inv; S[nt][j] = p; Pc[(fq * 4 + j) * 264 + nt * 16 + fr] = f2bf(p); }
            }
            asm volatile("s_waitcnt lgkmcnt(0)" ::: "memory");
#pragma unroll
            for (int nt = 0; nt < 16; ++nt)
#pragma unroll
                for (int j = 0; j < 4; ++j) {
                    const float v = S[nt][j];
                    float s4 = v + __shfl_xor(v, 1); s4 += __shfl_xor(s4, 2);
                    const float p3 = __shfl(v, lane | 3);
                    const float up = __shfl(v, (lane + 63) & 63);
                    const float vprev = nt > 0 ? S[nt > 0 ? nt - 1 : 0][j] : 0.f;
                    const float upp = __shfl(vprev, lane | 15);
                    const float pm1 = (fr == 0) ? upp : up;
                    if ((fr & 3) == 0) {
                        float* ip = imps + (fq * 4 + j) * 64 + nt * 4 + (fr >> 2);
                        const float val = s4 - 0.5f * p3 + 0.5f * pm1;
                        *ip = (r == 0) ? val : (*ip + val);
                    }
                }
            f32x4 Oc[8];
            float gcv[4];
#pragma unroll
            for (int j = 0; j < 4; ++j) gcv[j] = GT[(size_t)(b * SEQ + tokbase + fq * 4 + j) * 32 + g * 9 + r * 3 + 0];
#pragma unroll
            for (int dt = 0; dt < 8; ++dt) Oc[dt] = zero4();
#pragma unroll
            for (int half = 0; half < 2; ++half)
#pragma unroll
                for (int kg = 0; kg < 2; ++kg) {
                    if (2048 * kg + 31 > tmaxw) continue;
                    bf16x8 vf[16];
#pragma unroll
                    for (int i = 0; i < 16; ++i) vf[i] = *(const bf16x8*)(Vc + (size_t)((half * 4 + (i & 3)) * 16 + fr) * 256 + (kg * 4 + (i >> 2)) * 32 + fq * 8);
#pragma unroll
                    for (int k4 = 0; k4 < 4; ++k4) {
                        const bf16x8 av = *(const bf16x8*)(Pc + fr * 264 + (kg * 4 + k4) * 32 + fq * 8);
#pragma unroll
                        for (int dt = 0; dt < 4; ++dt) Oc[half * 4 + dt] = mfma16(av, vf[k4 * 4 + dt], Oc[half * 4 + dt]);
                    }
                }
#pragma unroll
            for (int j = 0; j < 4; ++j) {
                const int t = b * SEQ + tokbase + fq * 4 + j;
#pragma unroll
                for (int dt = 0; dt < 8; ++dt) Oc2[(size_t)t * 768 + (g * 3 + r) * 128 + dt * 16 + fr] = gcv[j] * Oc[dt][j];
            }
            asm volatile("s_waitcnt lgkmcnt(0)" ::: "memory");
        }
    }
    asm volatile("s_waitcnt lgkmcnt(0)" ::: "memory");
    {
        const int tk = lane >> 2, sub = lane & 3, tok = tokbase + tk, cur = tok >> 6;
        float* myimp = imps + tk * 64;
#pragma unroll
        for (int k4 = 0; k4 < 4; ++k4) {
            f32x4 v = *(const f32x4*)(myimp + sub * 16 + k4 * 4);
#pragma unroll
            for (int e = 0; e < 4; ++e) {
                const int m = sub * 16 + k4 * 4 + e;
                if (m > cur) v[e] = -1e9f;
                if (m == 0 || m == cur || m == cur - 1) v[e] = 1e9f;
            }
            *(f32x4*)(myimp + sub * 16 + k4 * 4) = v;
        }
        asm volatile("s_waitcnt lgkmcnt(0)" ::: "memory");
        int all[64];
#pragma unroll
        for (int m4 = 0; m4 < 16; ++m4) {
            const f32x4 v = *(const f32x4*)(myimp + m4 * 4);
#pragma unroll
            for (int e = 0; e < 4; ++e) {
                const unsigned u = __float_as_uint(v[e]);
                const unsigned ord = (u & 0x80000000u) ? ~u : (u | 0x80000000u);
                all[m4 * 4 + e] = (int)((((ord >> 1) & ~63u)) | (unsigned)(63 - (m4 * 4 + e)));
            }
        }
        unsigned part = 0;
#pragma unroll 1
        for (int k = 0; k < 16; ++k) {
            const int mi = sub * 16 + k;
            const unsigned u = __float_as_uint(((volatile float*)myimp)[mi]);
            const unsigned ord = (u & 0x80000000u) ? ~u : (u | 0x80000000u);
            const int kmi = (int)((((ord >> 1) & ~63u)) | (unsigned)(63 - mi));
            unsigned rank = 0;
#pragma unroll
            for (int m = 0; m < 64; ++m) rank += ((unsigned)(kmi - all[m])) >> 31;
            if (rank < 16u) part |= 1u << k;
        }
        unsigned long long mk = ((unsigned long long)part) << (sub * 16);
        unsigned lo = (unsigned)mk, hi = (unsigned)(mk >> 32);
        lo |= __shfl_xor(lo, 1); hi |= __shfl_xor(hi, 1); lo |= __shfl_xor(lo, 2); hi |= __shfl_xor(hi, 2);
        mk = ((unsigned long long)hi << 32) | lo;
        if (sub == 0) maskL[w * 16 + tk] = mk;
        unsigned ulo = lo, uhi = hi;
#pragma unroll
        for (int o = 4; o < 64; o <<= 1) { ulo |= __shfl_xor(ulo, o); uhi |= __shfl_xor(uhi, o); }
        if (lane == 0) wmL[w] = ((unsigned long long)uhi << 32) | ulo;
    }
    __syncthreads();
    unsigned long long un = 0;
#pragma unroll
    for (int i = 0; i < 8; ++i) un |= wmL[i];
    { const int kmax = (t0 + 127) >> 6; un &= (kmax >= 63) ? ~0ull : ((1ull << (kmax + 1)) - 1ull); }
    {
        unsigned long long* MG = WSP(unsigned long long, WS_MSK) + (size_t)(bg * 32 + qt) * 130;
        if (TIDX < 128) MG[TIDX] = maskL[TIDX];
        if (TIDX == 128) MG[128] = un;
    }
}

__device__ __forceinline__ void sel_head_item(const Args& a, int it, unsigned char* lds) {
    const int qt = 31 - it / 12, sub = it % 12, bg = sub & 3, r = sub >> 2, b = bg >> 1, g = bg & 1, t0 = qt * 128;
    const int tid = TIDX, w = tid >> 6, lane = tid & 63, fr = lane & 15, fq = lane >> 4;
    const int tokbase = t0 + 16 * w;
    const unsigned long long* MG = WSP(const unsigned long long, WS_MSK) + (size_t)(bg * 32 + qt) * 130;
    unsigned long long un = MG[128];
    un = ((unsigned long long)__builtin_amdgcn_readfirstlane((unsigned)(un >> 32)) << 32) | (unsigned)__builtin_amdgcn_readfirstlane((unsigned)un);
    const unsigned long long msk = MG[w * 16 + fr];
    const float* GT = WSP(const float, WS_GT);
    const float* On = WSP(const float, WS_ONSA);
    const float* Oc2 = WSP(const float, WS_ONC);
    const bf16_t* Kg = WSP(const bf16_t, WS_KS) + (size_t)bg * SEQ * 128;
    const bf16_t* Vtg = WSP(const bf16_t, WS_VST) + (size_t)bg * 128 * SEQ;
    bf16_t* Y = WSP(bf16_t, WS_Y);
    const bf16_t* qptr = WSP(const bf16_t, WS_QB) + (size_t)(b * SEQ + tokbase + fr) * 768 + (g * 3 + r) * 128 + fq * 8;
    f32x4 O[8]; float lrow;
    attn_head<1>(qptr, Kg, Vtg, un, tokbase + fr, msk, lds, O, lrow);
    {
        const int t = b * SEQ + tokbase + fr;
        const float sc = GT[(size_t)t * 32 + g * 9 + r * 3 + 1] / fmaxf(lrow, 1e-30f);
        f32x4 pv[8];
#pragma unroll
        for (int dt = 0; dt < 8; ++dt) {
            const size_t o = (size_t)t * 768 + (g * 3 + r) * 128 + dt * 16 + 4 * fq;
            pv[dt] = __builtin_nontemporal_load((const f32x4*)(On + o)) + __builtin_nontemporal_load((const f32x4*)(Oc2 + o));
        }
#pragma unroll
        for (int dt = 0; dt < 8; ++dt) {
            const f32x4 v = pv[dt] + O[dt] * sc;
            u32x2 pk; pk.x = pk2(v.x, v.y); pk.y = pk2(v.z, v.w);
            *(u32x2*)(Y + (size_t)t * DM + (g * 3 + r) * 128 + dt * 16 + 4 * fq) = pk;
        }
    }
}

__device__ __forceinline__ void post_item(const Args& a, int l, int it) {
    const int w = TIDX >> 6, lane = TIDX & 63;
    const float* P = WSP(const float, WS_P);
    bf16_t* Y = WSP(bf16_t, WS_Y);
    const float* nwg = AIN(17) + l * 128; const float* nwh = AIN(19) + l * 128;
    const float ng0 = nwg[lane], ng1 = nwg[64 + lane], nh0 = nwh[lane], nh1 = nwh[64 + lane];
#pragma unroll 1
    for (int tk = 0; tk < 4; ++tk) {
        const int t = it * 32 + w * 4 + tk;
        float o0[10], o1[10], z0[10], z1[10];
#pragma unroll
        for (int hh = 0; hh < 10; ++hh) {
            const int ty = hh / 5, h = hh % 5;
            const float* O = WSP(const float, ty ? WS_OH : WS_OG) + (size_t)t * 640 + h * 128;
            const float* z = P + (size_t)t * INP + (ty ? C_HG : C_GZ) + h * 128;
            o0[hh] = ldnt(O + lane); o1[hh] = ldnt(O + 64 + lane); z0[hh] = ldnt(z + lane); z1[hh] = ldnt(z + 64 + lane);
        }
#pragma unroll
        for (int hh = 0; hh < 10; ++hh) {
            const int ty = hh / 5, h = hh % 5;
            const float rs = rsqrtf(wave_sum(o0[hh] * o0[hh] + o1[hh] * o1[hh]) * (1.f / 128.f) + 1e-6f);
            bf16_t* y = Y + (size_t)t * DM + 768 + ty * 640 + h * 128;
            y[lane] = f2bf(o0[hh] * rs * (ty ? nh0 : ng0) * siluf_(z0[hh]));
            y[64 + lane] = f2bf(o1[hh] * rs * (ty ? nh1 : ng1) * siluf_(z1[hh]));
        }
    }
}

#ifndef PROBE_K
#define PROBE_K -1
#define PROBE_N 0
#endif
#ifndef PROBE_SUB
#define PROBE_SUB 15
#endif
#ifndef MULTI_LAUNCH
#define MULTI_LAUNCH 0
#endif
constexpr int DYN_LDS = 140 * 1024;
constexpr int N_PHASES = DEPTH * 12 + 1;

__device__ __forceinline__ int fetch_item(unsigned* ctr, unsigned char* lds) {
    volatile int* slot = (volatile int*)(lds + DYN_LDS - 16);
    lds_barrier();
    if (TIDX == 0) *slot = (int)atomicAdd(ctr, 1u);
    lds_barrier();
    const int v = *slot;
    return __builtin_amdgcn_readfirstlane(v);
}

struct ConvDesc { int in_idx; size_t src_off; int K, N; size_t dst_off; int mode, r; };
__device__ __forceinline__ void conv_decode(int T, int l, ConvDesc& d) {
    constexpr int TG = 32 * 44, TD = 88 * 16, TI = 32 * 59, TO = 32 * 16, TC1 = 64 * 1, TC2 = 2 * 1;
    const size_t lw = (size_t)l * DM * FF;
    int r = T;
    if (r < TG) { d = ConvDesc{2, lw, DM, FF, WS_WGU1, 1, r}; return; } r -= TG;
    if (r < TG) { d = ConvDesc{3, lw, DM, FF, WS_WGU1, 2, r}; return; } r -= TG;
    if (r < TD) { d = ConvDesc{4, lw, FF, DM, WS_WD1, 0, r}; return; } r -= TD;
    if (r < TG) { d = ConvDesc{21, lw, DM, FF, WS_WGU2, 1, r}; return; } r -= TG;
    if (r < TG) { d = ConvDesc{22, lw, DM, FF, WS_WGU2, 2, r}; return; } r -= TG;
    if (r < TD) { d = ConvDesc{23, lw, FF, DM, WS_WD2, 0, r}; return; } r -= TD;
    if (r < TI) { d = ConvDesc{6, (size_t)l * DM * INW, DM, INW, WS_WIN, 3, r}; return; } r -= TI;
    if (r < TO) { d = ConvDesc{7, (size_t)l * DM * DM, DM, DM, WS_WOUT, 0, r}; return; } r -= TO;
    if (r < TC1) { d = ConvDesc{10, (size_t)l * 4096 * 128, 4096, 128, WS_CK1, 0, r}; return; } r -= TC1;
    if (r < TC1) { d = ConvDesc{12, (size_t)l * 4096 * 128, 4096, 128, WS_CV1, 0, r}; return; } r -= TC1;
    if (r < TC2) { d = ConvDesc{11, (size_t)l * 128 * 128, 128, 128, WS_CK2, 0, r}; return; } r -= TC2;
    d = ConvDesc{13, (size_t)l * 128 * 128, 128, 128, WS_CV2, 0, r};
}
__device__ __forceinline__ void conv_load(const ConvDesc& d, f32x4 (&v)[4], int tid) {
    const float* W = (const float*)(__attribute__((address_space(1))) const float*)karg_u64(8 * d.in_idx) + d.src_off;
    const int nbn = (d.N + 127) / 128, kb = d.r / nbn, nb = d.r % nbn, k0 = kb * 64, n0 = nb * 128;
#pragma unroll
    for (int i = 0; i < 4; ++i) {
        const int idx = i * 512 + tid, kk = idx >> 5, n4 = (idx & 31) * 4;
        v[i] = zero4();
        if (n0 + n4 < d.N) v[i] = __builtin_nontemporal_load((const f32x4*)(W + (size_t)(k0 + kk) * d.N + n0 + n4));
    }
}
__device__ __forceinline__ void conv_store(const Args& a, const ConvDesc& d, const f32x4 (&v)[4], float* scr, int tid) {
    const int nbn = (d.N + 127) / 128, kb = d.r / nbn, nb = d.r % nbn, k0 = kb * 64, n0 = nb * 128;
    lds_barrier();
#pragma unroll
    for (int i = 0; i < 4; ++i) {
        const int idx = i * 512 + tid, kk = idx >> 5, n4 = (idx & 31) * 4;
        scr[(n4 + 0) * 65 + kk] = v[i].x; scr[(n4 + 1) * 65 + kk] = v[i].y; scr[(n4 + 2) * 65 + kk] = v[i].z; scr[(n4 + 3) * 65 + kk] = v[i].w;
    }
    lds_barrier();
#pragma unroll
    for (int h = 0; h < 2; ++h) {
        const int nn = h * 64 + (tid >> 3), kc = (tid & 7) * 8;
        if (n0 + nn < d.N) {
            const float* sp = scr + nn * 65 + kc;
            u32x4 o; o.x = pk2(sp[0], sp[1]); o.y = pk2(sp[2], sp[3]); o.z = pk2(sp[4], sp[5]); o.w = pk2(sp[6], sp[7]);
            *(u32x4*)(WSP(bf16_t, d.dst_off) + (size_t)rowmap(d.mode, n0 + nn) * d.K + k0 + kc) = o;
        }
    }
}
__device__ __forceinline__ void phase_convert(const Args& a, int l, unsigned char* lds) {
    float* scr = (float*)lds;
    constexpr int TG = 32 * 44, TD = 88 * 16, TI = 32 * 59, TO = 32 * 16, TC1 = 64 * 1, TC2 = 2 * 1;
    constexpr int TOTAL = 4 * TG + 2 * TD + TI + TO + 2 * TC1 + 2 * TC2;
    {
        const int tid = TIDX, G = GDIM;
        int T = BIDX;
        ConvDesc d0{}; f32x4 v[4];
        v[0] = zero4(); v[1] = zero4(); v[2] = zero4(); v[3] = zero4();
        if (T < TOTAL) { conv_decode(T, l, d0); conv_load(d0, v, tid); }
        while (T < TOTAL) {
            const int Tn = T + G;
            ConvDesc d1{}; f32x4 vn[4];
            vn[0] = zero4(); vn[1] = zero4(); vn[2] = zero4(); vn[3] = zero4();
            if (Tn < TOTAL) { conv_decode(Tn, l, d1); conv_load(d1, vn, tid); }
            conv_store(a, d0, v, scr, tid);
            d0 = d1; v[0] = vn[0]; v[1] = vn[1]; v[2] = vn[2]; v[3] = vn[3]; T = Tn;
        }
    }
    {
        u32x4* z = (u32x4*)(WSP(bf16_t, WS_WIN) + (size_t)INW * DM);
        const int nz = (INP - INW) * DM * 2 / 16;
        for (int i = BIDX * 512 + TIDX; i < nz; i += GDIM * 512) z[i] = __builtin_bit_cast(u32x4, zero4());
    }
    if (BIDX == 0) {
        for (int i = TIDX; i < 640; i += 512) {
            const float x0 = AIN(18)[i], x1 = AIN(18)[640 + i], m = fmaxf(x0, x1);
            const float e0 = __expf(x0 - m), e1 = __expf(x1 - m);
            WSP(float, WS_LB)[i] = 0.f; WSP(float, WS_LB)[640 + i] = e1 / (e0 + e1);
        }
    }
}

__device__ __forceinline__ void phase_rms_first(const Args& a, int l) {
    if (l != 0) return;
    const int lane = TIDX & 63, gw = BIDX * 8 + (TIDX >> 6), ngw = GDIM * 8;
    const float* g = AIN(1);
    float* ssq = WSP(float, WS_SSQ);
    bf16_t* XN = WSP(bf16_t, WS_XN);
    for (int r = gw; r < NT; r += ngw) {
        const f32x4* xr = (const f32x4*)(AIN(0) + (size_t)r * DM) + lane; f32x4* o = (f32x4*)(AOUT + (size_t)r * DM) + lane;
        u32x2* xo = (u32x2*)(XN + (size_t)r * DM) + lane;
        float s = 0.f;
        f32x4 vv[8], gv[8];
#pragma unroll
        for (int j = 0; j < 8; ++j) { vv[j] = __builtin_nontemporal_load(xr + 64 * j); gv[j] = ((const f32x4*)g)[lane + 64 * j]; }
#pragma unroll
        for (int j = 0; j < 8; ++j) {
            const f32x4 v = vv[j], gg = gv[j]; o[64 * j] = v;
            s += v.x * v.x + v.y * v.y + v.z * v.z + v.w * v.w;
            u32x2 w; w.x = pk2(v.x * gg.x, v.y * gg.y); w.y = pk2(v.z * gg.z, v.w * gg.w);
            xo[64 * j] = w;
        }
        s = wave_sum(s);
        if (lane < 8) ssq[(size_t)r * 8 + lane] = lane == 0 ? s : 0.f;
    }
}

__device__ __forceinline__ void phase_final(const Args& a) {
    const int lane = TIDX & 63, gw = BIDX * 8 + (TIDX >> 6), ngw = GDIM * 8;
    f32x4 gg[8];
#pragma unroll
    for (int j = 0; j < 8; ++j) gg[j] = ((const f32x4*)AIN(24))[lane + 64 * j];
    for (int r = gw; r < NT; r += ngw) {
        f32x4* xr = (f32x4*)(AOUT + (size_t)r * DM) + lane;
        f32x4 v[8]; float s = 0.f;
#pragma unroll
        for (int j = 0; j < 8; ++j) { v[j] = __builtin_nontemporal_load(xr + 64 * j); s += v[j].x * v[j].x + v[j].y * v[j].y + v[j].z * v[j].z + v[j].w * v[j].w; }
        const float rs = rsqrtf(wave_sum(s) * (1.f / DM) + 1e-6f);
#pragma unroll
        for (int j = 0; j < 8; ++j) xr[64 * j] = v[j] * rs * gg[j];
    }
}

template <int k>
__device__ __forceinline__ void run_phase_k(const Args& a, int l, unsigned char* lds, int& seq, int sub = 15) {
    bf16_t* shm = (bf16_t*)lds;
    const int gw = BIDX * 8 + (TIDX >> 6), ngw = GDIM * 8;
    unsigned* ctl = WSP(unsigned, WS_CTL);
    if (k == 12) { phase_final(a); return; }
    if (k == 0) { phase_convert(a, l, lds); phase_rms_first(a, l); }
    if (k == 1) gm::gemm_phase<gm::EPI_SWIGLU>(WSP(bf16_t, WS_XN), WSP(bf16_t, WS_WGU1), NT, 2 * FF, DM, shm, nullptr, WSP(bf16_t, WS_P), FF, 0.f, nullptr, nullptr, nullptr, WSP(const float, WS_SSQ) + (size_t)(l * 3 + 0) * NT * 8);
    if (k == 2) gm::gemm_phase<gm::EPI_RESID>(WSP(bf16_t, WS_P), WSP(bf16_t, WS_WD1), NT, DM, FF, shm, AOUT, nullptr, DM, 0.5f, AIN(5) + l * DM, WSP(bf16_t, WS_XN), WSP(float, WS_SSQ) + (size_t)(l * 3 + 1) * NT * 8, nullptr);
    if (k == 4) gm::gemm_phase<gm::EPI_STORE>(WSP(bf16_t, WS_XN), WSP(bf16_t, WS_WIN), NT, INP, DM, shm, WSP(float, WS_P), nullptr, INP, 0.f, nullptr, nullptr, nullptr, WSP(const float, WS_SSQ) + (size_t)(l * 3 + 1) * NT * 8);
    if (k == 5) {
        while (true) {
            const int it = fetch_item(ctl + 128 + l, lds);
            if (it >= 640 + 640 + 512 + 256) break;
            if (it < 640) { if (sub & 1) gdn_chunk(a, l, it, lds); }
            else if (it < 1280) { if (sub & 2) hgrn_chunk(a, l, it - 640, lds); }
            else if (it < 1792) { if (sub & 4) vtrans_item(a, it - 1280, lds); }
            else { if (sub & 8) { for (int q = 0; q < 4; ++q) nsa_prep_token(a, (it - 1792) * 32 + q * 8 + (TIDX >> 6), TIDX & 63); } }
        }
    }
    if (k == 6) {
        while (true) {
            const int it = fetch_item(ctl + seq, lds);
            if (it >= 128 + 160 + 128 + 384) break;
            if (it < 128) { if (sub & 2) compress_item(a, l, it, lds, ctl + 64 + seq); }
            else if (it < 288) { if (sub & 1) { if (it - 128 < 80) scan_task<0>(a, it - 128, lds); else scan_task<1>(a, it - 208, lds); } }
            else if (it < 416) { if (sub & 8) cmpsel_item(a, it - 288, lds, (sub & 2) ? ctl + 64 + seq : ctl + 64); }
            else { if (sub & 4) window_item(a, it - 416, lds); }
        }
        ++seq;
    }
    if (k == 7) {
        while (true) {
            const int it = fetch_item(ctl + seq, lds);
            if (it >= 384 + 256) break;
            if (it < 384) sel_head_item(a, it, lds); else post_item(a, l, it - 384);
        }
        ++seq;
    }
    if (k == 8) gm::gemm_phase<gm::EPI_RESID>(WSP(bf16_t, WS_Y), WSP(bf16_t, WS_WOUT), NT, DM, DM, shm, AOUT, nullptr, DM, 1.0f, AIN(20) + l * DM, WSP(bf16_t, WS_XN), WSP(float, WS_SSQ) + (size_t)(l * 3 + 2) * NT * 8, nullptr);
    if (k == 10) gm::gemm_phase<gm::EPI_SWIGLU>(WSP(bf16_t, WS_XN), WSP(bf16_t, WS_WGU2), NT, 2 * FF, DM, shm, nullptr, WSP(bf16_t, WS_P), FF, 0.f, nullptr, nullptr, nullptr, WSP(const float, WS_SSQ) + (size_t)(l * 3 + 2) * NT * 8);
    if (k == 11) {
        if (l + 1 < DEPTH) gm::gemm_phase<gm::EPI_RESID>(WSP(bf16_t, WS_P), WSP(bf16_t, WS_WD2), NT, DM, FF, shm, AOUT, nullptr, DM, 0.5f, AIN(1) + (l + 1) * DM, WSP(bf16_t, WS_XN), WSP(float, WS_SSQ) + (size_t)((l + 1) * 3 + 0) * NT * 8, nullptr);
        else gm::gemm_phase<gm::EPI_RESID>(WSP(bf16_t, WS_P), WSP(bf16_t, WS_WD2), NT, DM, FF, shm, AOUT, nullptr, DM, 0.5f, nullptr, nullptr, nullptr, nullptr);
    }
}

__device__ __forceinline__ void run_phase(const Args& a, int ph, unsigned char* lds, int& seq, int sub = 15) {
    if (ph == DEPTH * 12) { run_phase_k<12>(a, 0, lds, seq); return; }
    const int l = ph / 12, k = ph % 12;
    switch (k) {
    case 0: run_phase_k<0>(a, l, lds, seq); break;
    case 1: run_phase_k<1>(a, l, lds, seq); break;
    case 2: run_phase_k<2>(a, l, lds, seq); break;
    case 3: run_phase_k<3>(a, l, lds, seq); break;
    case 4: run_phase_k<4>(a, l, lds, seq); break;
    case 5: run_phase_k<5>(a, l, lds, seq, sub); break;
    case 6: run_phase_k<6>(a, l, lds, seq, sub); break;
    case 7: run_phase_k<7>(a, l, lds, seq); break;
    case 8: run_phase_k<8>(a, l, lds, seq); break;
    case 9: run_phase_k<9>(a, l, lds, seq); break;
    case 10: run_phase_k<10>(a, l, lds, seq); break;
    case 11: run_phase_k<11>(a, l, lds, seq); break;
    }
}

template <int k>
__global__ __launch_bounds__(512, 2) void phk(Args a) {
    extern __shared__ __attribute__((aligned(16))) unsigned char lds[];
    int seq = (a.ph_lo / 12) * 2 + ((a.ph_lo % 12) == 7 ? 1 : 0);
    run_phase_k<k>(a, a.ph_lo / 12, lds, seq);
}

#define XB_TMO      128
#define XB_XCNT(j)  (256  + 64 * (j))
#define XB_XSUB(j)  (1280 + 64 * (j))
#define XB_XGEN(j)  (2304 + 64 * (j))
#define XB_TOP      3328
#define XB_TOPGEN   3392
#define XB_SPIN_CAP (1u << 20)
#define LAS3 __attribute__((address_space(3)))
__device__ __forceinline__ unsigned xb_xcc_id() { return (unsigned)__builtin_amdgcn_s_getreg((3 << 11) | 20) & 0xFu; }
#define XB_SPIN(cond, bar) do { unsigned _sp = 0; while (cond) { __builtin_amdgcn_s_sleep(1); \
    if ((++_sp & 255u) == 0u) { if (xb_ld(&(bar)[XB_TMO])) break; if (_sp > XB_SPIN_CAP) { atomicAdd(&(bar)[XB_TMO], 1u); break; } } } } while (0)
struct XcdBarrier { unsigned* bar; unsigned x; volatile LAS3 unsigned* st; };
__device__ __forceinline__ XcdBarrier xcd_barrier_post(unsigned* bar, volatile LAS3 unsigned* st) {
    XcdBarrier b; b.bar = bar; b.x = xb_xcc_id(); b.st = st;
    if (threadIdx.x == 0) (void)xb_add(&bar[XB_XCNT(b.x)], 1u);
    return b;
}
__device__ __forceinline__ void xcd_barrier_complete(unsigned* bar, unsigned x, unsigned& nloc, unsigned& nx) {
    const unsigned G = gridDim.x * gridDim.y * gridDim.z;
    unsigned sum, cnt, mine, sp = 0u;
    for (;;) {
        sum = 0u; cnt = 0u; mine = 0u;
#pragma unroll
        for (unsigned j = 0; j < 16; ++j) { const unsigned c = xb_ld(&bar[XB_XCNT(j)]); sum += c; cnt += (c > 0u) ? 1u : 0u; mine = (j == x) ? c : mine; }
        if (sum == G) break;
        __builtin_amdgcn_s_sleep(1);
        if ((++sp & 255u) == 0u) { if (xb_ld(&bar[XB_TMO])) break; if (sp > XB_SPIN_CAP) { atomicAdd(&bar[XB_TMO], 1u); break; } }
    }
    nloc = mine > 0u ? mine : 1u; nx = cnt > 0u ? cnt : 1u;
}
__device__ __forceinline__ void xcd_barrier(const XcdBarrier& b) {
    asm volatile("s_waitcnt vmcnt(0)" ::: "memory");
    __syncthreads();
    if (threadIdx.x == 0) {
        unsigned* bar = b.bar;
        __builtin_amdgcn_s_waitcnt(0);
        unsigned nloc = b.st[0], nx = b.st[1];
        if (nloc == 0u) { xcd_barrier_complete(bar, b.x, nloc, nx); b.st[0] = nloc; b.st[1] = nx; }
        const unsigned old = xb_add(&bar[XB_XSUB(b.x)], 1u);
        const unsigned gen = old / nloc;
        if (old + 1u == (gen + 1u) * nloc) {
            __builtin_amdgcn_fence(__ATOMIC_RELEASE, "agent");
            asm volatile("s_waitcnt vmcnt(0)" ::: "memory");
            const unsigned og = xb_add(&bar[XB_TOP], 1u);
            const unsigned tg = og / nx;
            if (og + 1u == (tg + 1u) * nx) xb_add(&bar[XB_TOPGEN], 1u);
            else XB_SPIN(xb_ld(&bar[XB_TOPGEN]) == tg, bar);
            __builtin_amdgcn_fence(__ATOMIC_ACQUIRE, "agent");
            xb_add(&bar[XB_XGEN(b.x)], 1u);
            asm volatile("s_waitcnt vmcnt(0)" ::: "memory");
        } else {
            XB_SPIN(xb_ld(&bar[XB_XGEN(b.x)]) == gen, bar);
            __builtin_amdgcn_fence(__ATOMIC_ACQUIRE, "agent");
            asm volatile("s_waitcnt vmcnt(0)" ::: "memory");
        }
    }
    __syncthreads();
}

#if !MULTI_LAUNCH
__global__ __launch_bounds__(512, 2) void mega(Args a) {
    extern __shared__ __attribute__((aligned(16))) unsigned char lds[];
    cg::grid_group grid = cg::this_grid();
    volatile LAS3 unsigned* xst = (volatile LAS3 unsigned*)(lds + DYN_LDS - 64);
    if (threadIdx.x == 0) { xst[0] = 0u; xst[1] = 0u; }
    __syncthreads();
    XcdBarrier xb = xcd_barrier_post((unsigned*)(a.ws + WS_BAR), xst);
#define SEAM(ph) do { if ((ph) == a.ph_lo) grid.sync(); else xcd_barrier(xb); } while (0)
    int seq = 0;
    for (int ph = a.ph_lo; ph < a.ph_hi; ++ph) {
        if (ph < DEPTH * 12 && ((ph % 12) == 3 || (ph % 12) == 9)) continue;
        run_phase(a, ph, lds, seq);
#if PROBE_N > 0
        if (PROBE_K >= 0 && ph < DEPTH * 12 && (ph % 12) == PROBE_K) for (int rep = 0; rep < PROBE_N; ++rep) { SEAM(ph); run_phase(a, ph, lds, seq, PROBE_SUB); }
        if (PROBE_K == -2 && ph + 1 < a.ph_hi) for (int rep = 0; rep < PROBE_N; ++rep) SEAM(ph);
#endif
        if (ph + 1 < a.ph_hi) SEAM(ph);
    }
}
#define MAINK mega
#else
#define MAINK phk<0>
#endif

extern "C" void kernel_launch(void* const* d_in, const int* in_sizes, int n_in, void* d_out, int out_size, void* d_ws, size_t ws_size, hipStream_t stream) {
    static int grid = 0;
    if (grid == 0) {
        if (n_in != 25 || out_size != NT * DM || ws_size < WS_END) {
            fprintf(stderr, "kernel_launch: unexpected shapes: n_in %d out %d ws %zu (need %zu)\n", n_in, out_size, ws_size, (size_t)WS_END);
            grid = -1; return;
        }
        int dev = 0, cus = 0, per_cu = 0;
        hipGetDevice(&dev);
        hipDeviceGetAttribute(&cus, hipDeviceAttributeMultiprocessorCount, dev);
        if (hipFuncSetAttribute((const void*)MAINK, hipFuncAttributeMaxDynamicSharedMemorySize, DYN_LDS) != hipSuccess) { fprintf(stderr, "kernel_launch: hipFuncSetAttribute failed\n"); grid = -1; return; }
#if MULTI_LAUNCH
#define SK(K) (void)hipFuncSetAttribute((const void*)phk<K>, hipFuncAttributeMaxDynamicSharedMemorySize, DYN_LDS);
        SK(0) SK(1) SK(2) SK(3) SK(4) SK(5) SK(6) SK(7) SK(8) SK(9) SK(10) SK(11) SK(12)
#undef SK
#endif
        if (hipOccupancyMaxActiveBlocksPerMultiprocessor(&per_cu, (const void*)MAINK, 512, DYN_LDS) != hipSuccess || per_cu < 1) { per_cu = 1; (void)hipGetLastError(); }
        grid = cus * per_cu;
        if (grid <= 0) grid = 256;
    }
    if (grid < 0) return;
    (void)hipMemsetAsync((char*)d_ws + WS_CTL, 0, 32768, stream);
    Args a{};
    for (int i = 0; i < 25; ++i) a.in[i] = (const float*)d_in[i];
    a.out = (float*)d_out; a.ws = (unsigned char*)d_ws;
#if MULTI_LAUNCH
    for (int ph = 0; ph < N_PHASES; ++ph) {
        a.ph_lo = ph; a.ph_hi = ph + 1;
        const int k = ph == DEPTH * 12 ? 12 : ph % 12;
#define LK(K) case K: hipLaunchKernelGGL(phk<K>, dim3(grid), dim3(512), DYN_LDS, stream, a); break;
        switch (k) { LK(0) LK(1) LK(2) LK(3) LK(4) LK(5) LK(6) LK(7) LK(8) LK(9) LK(10) LK(11) LK(12) }
#undef LK
    }
#else
    a.ph_lo = 0; a.ph_hi = N_PHASES;
    void* args[] = {&a};
    hipError_t e = hipLaunchCooperativeKernel((const void*)MAINK, dim3(grid), dim3(512), args, DYN_LDS, stream);
    if (e != hipSuccess) fprintf(stderr, "cooperative launch failed: %s (grid %d)\n", hipGetErrorString(e), grid);
#endif
}
```

```cpp
#include <hip/hip_runtime.h>
#include <hip/hip_cooperative_groups.h>
#include <cstdio>
#include <cstdint>
namespace cg = cooperative_groups;

typedef unsigned short bf16_t;
typedef short bf16x8 __attribute__((ext_vector_type(8)));
typedef float f32x4 __attribute__((ext_vector_type(4)));
typedef unsigned u32x4 __attribute__((ext_vector_type(4)));
typedef unsigned u32x2 __attribute__((ext_vector_type(2)));

constexpr int DM = 2048, NB = 2, SEQ = 4096, NT = NB * SEQ, DEPTH = 2, FF = 5632, HD = 128;
constexpr int INW = 7452, INP = 7680;
constexpr int C_NQ = 0, C_NKC = 768, C_NVC = 1024, C_NKS = 1280, C_NVS = 1536, C_NKW = 1792, C_NVW = 2048;
constexpr int C_GQ = 2304, C_GK = 2944, C_GV = 3584, C_GZ = 4224, C_HQ = 4864, C_HF = 5504, C_HI = 6144, C_HG = 6784;
constexpr int C_NGT = 7424, C_GA = 7442, C_GB = 7447;
constexpr int NCH = 64;
constexpr int NCI = NB * 5 * NCH;

constexpr size_t al(size_t x) { return (x + 255) & ~(size_t)255; }
constexpr size_t WS_CTL = 0;
constexpr size_t WS_BAR = 4096;
constexpr size_t WS_WGU1 = 32768;
constexpr size_t WS_WD1 = WS_WGU1 + (size_t)2 * FF * DM * 2;
constexpr size_t WS_WGU2 = WS_WD1 + (size_t)DM * FF * 2;
constexpr size_t WS_WD2 = WS_WGU2 + (size_t)2 * FF * DM * 2;
constexpr size_t WS_WIN = WS_WD2 + (size_t)DM * FF * 2;
constexpr size_t WS_WOUT = WS_WIN + (size_t)INP * DM * 2;
constexpr size_t WS_CK1 = WS_WOUT + (size_t)DM * DM * 2;
constexpr size_t WS_CV1 = WS_CK1 + (size_t)128 * 4096 * 2;
constexpr size_t WS_CK2 = WS_CV1 + (size_t)128 * 4096 * 2;
constexpr size_t WS_CV2 = WS_CK2 + (size_t)128 * 128 * 2;
constexpr size_t WS_XN = WS_CV2 + (size_t)128 * 128 * 2;
constexpr size_t WS_Y = WS_XN + (size_t)NT * DM * 2;
constexpr size_t WS_P = WS_Y + (size_t)NT * DM * 2;
constexpr size_t WS_QB = WS_P + (size_t)NT * INP * 4;
constexpr size_t WS_KCR = WS_QB + (size_t)NT * 768 * 2;
constexpr size_t WS_VCR = WS_KCR + (size_t)NT * 256 * 4;
constexpr size_t WS_KS = WS_VCR + (size_t)NT * 256 * 4;
constexpr size_t WS_KW = WS_KS + (size_t)NT * 256 * 2;
constexpr size_t WS_VST = WS_KW + (size_t)NT * 256 * 2;
constexpr size_t WS_VWT = WS_VST + (size_t)NT * 256 * 2;
constexpr size_t WS_KCB = WS_VWT + (size_t)NT * 256 * 2;
constexpr size_t WS_VCT = WS_KCB + (size_t)4 * 256 * 128 * 2;
constexpr size_t WS_GT = WS_VCT + (size_t)4 * 256 * 128 * 2;
constexpr size_t WS_ONSA = WS_GT + (size_t)NT * 32 * 4;
constexpr size_t WS_GU = WS_ONSA + (size_t)NT * 768 * 4;
constexpr size_t WS_GWN = WS_GU + (size_t)NCI * 64 * 128 * 4;
constexpr size_t WS_GQD = WS_GWN + (size_t)NCI * 64 * 128 * 2;
constexpr size_t WS_GKT = WS_GQD + (size_t)NCI * 64 * 128 * 2;
constexpr size_t WS_GAT = WS_GKT + (size_t)NCI * 64 * 128 * 2;
constexpr size_t WS_GLAST = WS_GAT + (size_t)NCI * 64 * 64 * 2;
constexpr size_t WS_HQE = WS_GLAST + al((size_t)NCI * 4);
constexpr size_t WS_HKT = WS_HQE + (size_t)NCI * 64 * 128 * 2;
constexpr size_t WS_HAM = WS_HKT + (size_t)NCI * 64 * 128 * 2;
constexpr size_t WS_HVT = WS_HAM + (size_t)NCI * 64 * 64 * 2;
constexpr size_t WS_HDL = WS_HVT + (size_t)NCI * 64 * 128 * 2;
constexpr size_t WS_OG = WS_HDL + (size_t)NCI * 128 * 4;
constexpr size_t WS_OH = WS_OG + (size_t)NT * 640 * 4;
constexpr size_t WS_LB = WS_OH + (size_t)NT * 640 * 4;
constexpr size_t WS_ONC = WS_LB + al((size_t)2 * 640 * 4);
constexpr size_t WS_MSK = WS_ONC + (size_t)NT * 768 * 4;
constexpr size_t WS_SSQ = WS_MSK + al((size_t)128 * 130 * 8);
constexpr size_t WS_END = WS_SSQ + (size_t)6 * NT * 8 * 4;

constexpr int LDS_BYTES = 160 * 1024;

struct Args {
    const float* in[25];
    float* out;
    unsigned char* ws;
    int ph_lo, ph_hi;
};

__device__ __forceinline__ int opaque_tid() { int t = threadIdx.x; asm volatile("" : "+v"(t)); return t; }
__device__ __forceinline__ int opaque_bid() { int t = blockIdx.x; asm volatile("" : "+s"(t)); return t; }
__device__ __forceinline__ int opaque_gdim() { int t = gridDim.x; asm volatile("" : "+s"(t)); return t; }
typedef const __attribute__((address_space(4))) unsigned char* kas_ptr;
__device__ __forceinline__ unsigned long long karg_u64(int byte_off) {
    kas_ptr kp = (kas_ptr)__builtin_amdgcn_kernarg_segment_ptr();
    asm volatile("" : "+s"(kp));
    return *(const __attribute__((address_space(4))) unsigned long long*)(kp + byte_off);
}
#define TIDX opaque_tid()
#define BIDX opaque_bid()
#define GDIM opaque_gdim()
#define AIN(i) ((const float*)(__attribute__((address_space(1))) const float*)karg_u64(8 * (i)))
#define AOUT ((float*)(__attribute__((address_space(1))) float*)karg_u64(200))
#define AWS ((unsigned char*)karg_u64(208))
__device__ __forceinline__ unsigned short f2bf(float f) { __bf16 b = (__bf16)f; return __builtin_bit_cast(unsigned short, b); }
typedef float f32x2_t __attribute__((ext_vector_type(2)));
typedef __bf16 bf16x2_t __attribute__((ext_vector_type(2)));
__device__ __forceinline__ unsigned pk2(float lo, float hi) { f32x2_t v = {lo, hi}; bf16x2_t b = __builtin_convertvector(v, bf16x2_t); return __builtin_bit_cast(unsigned, b); }
__device__ __forceinline__ float bf2f(unsigned short h) { return __uint_as_float(((unsigned)h) << 16); }
__device__ __forceinline__ float wave_sum(float v) {
#pragma unroll
    for (int o = 1; o < 64; o <<= 1) v += __shfl_xor(v, o);
    return v;
}
__device__ __forceinline__ float sigmoidf_(float x) { return __builtin_amdgcn_rcpf(1.f + __expf(-x)); }
__device__ __forceinline__ float siluf_(float x) { return x * __builtin_amdgcn_rcpf(1.f + __expf(-x)); }
__device__ __forceinline__ const float* sel_ptr(bool c, const float* x, const float* y) {
    unsigned long long xv = (unsigned long long)x, yv = (unsigned long long)y;
    asm volatile("" : "+s"(xv), "+s"(yv));
    return (const float*)(c ? xv : yv);
}
__device__ __forceinline__ float ldnt(const float* p) { return __builtin_nontemporal_load(p); }
__device__ __forceinline__ void lds_barrier() { asm volatile("s_waitcnt lgkmcnt(0)\n\ts_barrier" ::: "memory"); }
__device__ __forceinline__ unsigned xb_ld(unsigned* p)              { return __hip_atomic_load(p, __ATOMIC_RELAXED, __HIP_MEMORY_SCOPE_AGENT); }
__device__ __forceinline__ unsigned xb_add(unsigned* p, unsigned v) { return __hip_atomic_fetch_add(p, v, __ATOMIC_RELAXED, __HIP_MEMORY_SCOPE_AGENT); }
__device__ __forceinline__ f32x4 zero4() {
    int z = 0; asm volatile("" : "+s"(z));
    const float zf = __int_as_float(z);
    return (f32x4){zf, zf, zf, zf};
}
__device__ __forceinline__ f32x4 mfma16(bf16x8 a, bf16x8 b, f32x4 c) { return __builtin_amdgcn_mfma_f32_16x16x32_bf16(a, b, c, 0, 0, 0); }

__device__ __forceinline__ int win_newcol(int o) {
    if (o < 2304) return o;
    if (o < 2322) return C_NGT + (o - 2304);
    if (o < 4242) return C_GQ + (o - 2322);
    if (o < 4247) return C_GA + (o - 4242);
    if (o < 4252) return C_GB + (o - 4247);
    return C_GZ + (o - 4252);
}
__device__ __forceinline__ int rowmap(int mode, int n) {
    if (mode == 0) return n;
    if (mode == 1) return (n >> 7) * 256 + (n & 127);
    if (mode == 2) return (n >> 7) * 256 + 128 + (n & 127);
    return win_newcol(n);
}
__device__ __forceinline__ void conv_tile(const float* W, int K, int N, bf16_t* WT, int mode, int tile, float* scr) {
    const int nbn = (N + 63) / 64, kb = tile / nbn, nb = tile % nbn, k0 = kb * 64, n0 = nb * 64;
    const int tid = TIDX;
    __syncthreads();
#pragma unroll
    for (int i = 0; i < 8; ++i) {
        const int kk = i * 8 + (tid >> 6), nn = tid & 63;
        float v = 0.f;
        if (n0 + nn < N) v = W[(size_t)(k0 + kk) * N + n0 + nn];
        scr[nn * 65 + kk] = v;
    }
    __syncthreads();
    const int nn = tid >> 3, kc = (tid & 7) * 8;
    if (n0 + nn < N) {
        const float* s = scr + nn * 65 + kc;
        u32x4 o; o.x = pk2(s[0], s[1]); o.y = pk2(s[2], s[3]); o.z = pk2(s[4], s[5]); o.w = pk2(s[6], s[7]);
        *(u32x4*)(WT + (size_t)rowmap(mode, n0 + nn) * K + k0 + kc) = o;
    }
}

__device__ __forceinline__ void rms_rows_bf16(const float* x, const float* g, bf16_t* out, int gw, int ngw) {
    const int lane = TIDX & 63;
    for (int r = gw; r < NT; r += ngw) {
        const f32x4* xr = (const f32x4*)(x + (size_t)r * DM) + lane;
        f32x4 v[8]; float s = 0.f;
#pragma unroll
        for (int j = 0; j < 8; ++j) { v[j] = xr[64 * j]; s += v[j].x * v[j].x + v[j].y * v[j].y + v[j].z * v[j].z + v[j].w * v[j].w; }
        const float rs = rsqrtf(wave_sum(s) * (1.f / DM) + 1e-6f);
        u32x2* o = (u32x2*)(out + (size_t)r * DM) + lane;
#pragma unroll
        for (int j = 0; j < 8; ++j) {
            const f32x4 gg = ((const f32x4*)g)[lane + 64 * j];
            u32x2 w; w.x = pk2(v[j].x * rs * gg.x, v[j].y * rs * gg.y); w.y = pk2(v[j].z * rs * gg.z, v[j].w * rs * gg.w);
            o[64 * j] = w;
        }
    }
}

namespace gm {
constexpr int BM = 256, BK = 64, HALF = 128, NXCD = 8, WGM = 8, HT = HALF * BK;
__device__ __forceinline__ int lds_byte(int r, int c) {
    int st = (r >> 4) * 2 + (c >> 5), rr = r & 15, cc = c & 31, ob = rr * 64 + cc * 2;
    return st * 1024 + (ob ^ (((ob >> 9) & 1) << 5));
}
__device__ __forceinline__ void stage_rc(int b, int& R, int& C) {
    int st = b / 1024, sb = b % 1024, swz = sb ^ (((sb >> 9) & 1) << 5);
    R = (st >> 1) * 16 + swz / 64; C = (st & 1) * 32 + (swz % 64) / 2;
}
enum { EPI_SWIGLU = 0, EPI_RESID = 1, EPI_STORE = 2 };

template <int EPI>
__device__ __forceinline__ void epilogue(const f32x4 (&acc)[2][2][4][2], int brow, int bcol, float* __restrict__ Cf, bf16_t* __restrict__ Cb, int ldc, float scale,
                                         const float* __restrict__ gvec, bf16_t* __restrict__ XNout, float* __restrict__ ssq_out, const float* __restrict__ ssq_in, float* sred) {
    int tz = threadIdx.x; asm volatile("" : "+v"(tz));
    const int wid = tz >> 6, lane = tz & 63, wr = wid >> 2, wc = wid & 3, fr = lane & 15, fq = lane >> 4;
    const int row0 = brow + wr * 64 + fr;
    if (EPI == EPI_SWIGLU || EPI == EPI_STORE) {
        float rs[2][4];
#pragma unroll
        for (int ai = 0; ai < 2; ++ai)
#pragma unroll
            for (int m = 0; m < 4; ++m) {
                const f32x4 q0 = *(const f32x4*)(ssq_in + (size_t)(row0 + ai * HALF + m * 16) * 8), q1 = *(const f32x4*)(ssq_in + (size_t)(row0 + ai * HALF + m * 16) * 8 + 4);
                rs[ai][m] = rsqrtf((((q0.x + q0.y) + (q0.z + q0.w)) + ((q1.x + q1.y) + (q1.z + q1.w))) * (1.f / DM) + 1e-6f);
            }
        if (EPI == EPI_SWIGLU) {
            bf16_t* base = Cb + (size_t)row0 * ldc + (bcol >> 1) + wc * 32 + 4 * fq;
#pragma unroll
            for (int ai = 0; ai < 2; ++ai)
#pragma unroll
                for (int m = 0; m < 4; ++m)
#pragma unroll
                    for (int n = 0; n < 2; ++n) {
                        const f32x4 g = acc[ai][0][m][n] * rs[ai][m], u = acc[ai][1][m][n] * rs[ai][m];
                        u32x2 o; o.x = pk2(siluf_(g.x) * u.x, siluf_(g.y) * u.y); o.y = pk2(siluf_(g.z) * u.z, siluf_(g.w) * u.w);
                        *(u32x2*)(base + (size_t)(ai * HALF + m * 16) * ldc + n * 16) = o;
                    }
        } else {
            float* base = Cf + (size_t)row0 * ldc + bcol + wc * 32 + 4 * fq;
#pragma unroll
            for (int ai = 0; ai < 2; ++ai)
#pragma unroll
                for (int m = 0; m < 4; ++m)
#pragma unroll
                    for (int bj = 0; bj < 2; ++bj)
#pragma unroll
                        for (int n = 0; n < 2; ++n) *(f32x4*)(base + (size_t)(ai * HALF + m * 16) * ldc + bj * HALF + n * 16) = acc[ai][bj][m][n] * rs[ai][m];
        }
    } else {
        const int col0 = bcol + wc * 32 + 4 * fq;
        float* base = Cf + (size_t)row0 * ldc + col0;
        f32x4 gg[2][2];
        if (gvec) {
#pragma unroll
            for (int bj = 0; bj < 2; ++bj)
#pragma unroll
                for (int n = 0; n < 2; ++n) gg[bj][n] = *(const f32x4*)(gvec + col0 + bj * HALF + n * 16);
        }
#pragma unroll
        for (int ai = 0; ai < 2; ++ai) {
            f32x4 xv[4][2][2];
#pragma unroll
            for (int m = 0; m < 4; ++m)
#pragma unroll
                for (int bj = 0; bj < 2; ++bj)
#pragma unroll
                    for (int n = 0; n < 2; ++n) xv[m][bj][n] = __builtin_nontemporal_load((const f32x4*)(base + (size_t)(ai * HALF + m * 16) * ldc + bj * HALF + n * 16));
#pragma unroll
            for (int m = 0; m < 4; ++m) {
                float ss = 0.f;
#pragma unroll
                for (int bj = 0; bj < 2; ++bj)
#pragma unroll
                    for (int n = 0; n < 2; ++n) {
                        const f32x4 xn = xv[m][bj][n] + acc[ai][bj][m][n] * scale;
                        *(f32x4*)(base + (size_t)(ai * HALF + m * 16) * ldc + bj * HALF + n * 16) = xn;
                        if (gvec) {
                            ss += xn.x * xn.x + xn.y * xn.y + xn.z * xn.z + xn.w * xn.w;
                            u32x2 o; o.x = pk2(xn.x * gg[bj][n].x, xn.y * gg[bj][n].y); o.y = pk2(xn.z * gg[bj][n].z, xn.w * gg[bj][n].w);
                            *(u32x2*)(XNout + (size_t)(row0 + ai * HALF + m * 16) * ldc + col0 + bj * HALF + n * 16) = o;
                        }
                    }
                if (gvec) {
                    ss += __shfl_xor(ss, 16); ss += __shfl_xor(ss, 32);
                    if (fq == 0) sred[(ai * HALF + wr * 64 + m * 16 + fr) * 4 + wc] = ss;
                }
            }
        }
        if (gvec) {
            lds_barrier();
            if (tz < 256) { const f32x4 p = *(const f32x4*)(sred + tz * 4); ssq_out[(size_t)(brow + tz) * 8 + (bcol >> 8)] = (p.x + p.y) + (p.z + p.w); }
        }
    }
}

template <int EPI>
__device__ __forceinline__ void gemm_unit(const bf16_t* A, const bf16_t* Bt, int K, int brow, int bcol, bf16_t* shm,
                                          float* Cf, bf16_t* Cb, int ldc, float scale, const float* gvec, bf16_t* XNout, float* ssq_out, const float* ssq_in) {
#define SA(b, h) (shm + ((b) * 2 + (h)) * HT)
#define SB(b, h) (shm + (4 + (b) * 2 + (h)) * HT)
#define STAGE(P, BASE, br, kt) do { const bf16_t* _gb = (BASE) + ((long)(br) * K + (long)(kt) * BK); \
    __builtin_amdgcn_global_load_lds((const unsigned*)(_gb + so0), (__attribute__((address_space(3))) unsigned*)((char*)(P) + tzz * 16), 16, 0, 0); \
    __builtin_amdgcn_global_load_lds((const unsigned*)(_gb + so1), (__attribute__((address_space(3))) unsigned*)((char*)(P) + tzz * 16 + 8192), 16, 0, 0); } while (0)
#define LDA(dst, b, h) for (int m = 0; m < 4; ++m) for (int k = 0; k < 2; ++k) \
    dst[m][k] = *reinterpret_cast<const bf16x8*>((char*)SA(b, h) + lds_byte(wr * 64 + m * 16 + fr, k * 32 + fq * 8))
#define LDB(dst, b, h) for (int n = 0; n < 2; ++n) for (int k = 0; k < 2; ++k) \
    dst[n][k] = *reinterpret_cast<const bf16x8*>((char*)SB(b, h) + lds_byte(wc * 32 + n * 16 + fr, k * 32 + fq * 8))
#define MMA(ai, bj, At, Bt_) do { __builtin_amdgcn_s_setprio(1); \
    for (int m = 0; m < 4; ++m) for (int n = 0; n < 2; ++n) for (int k = 0; k < 2; ++k) \
      acc[ai][bj][m][n] = __builtin_amdgcn_mfma_f32_16x16x32_bf16(Bt_[n][k], At[m][k], acc[ai][bj][m][n], 0, 0, 0); \
    __builtin_amdgcn_s_setprio(0); } while (0)
#define WAIT_V(n) asm volatile("s_waitcnt vmcnt(" #n ")" ::: "memory")
#define WAIT_L(n) asm volatile("s_waitcnt lgkmcnt(" #n ")" ::: "memory")
#define BAR __builtin_amdgcn_s_barrier()
#define SCHED __builtin_amdgcn_sched_barrier(0)
    int tzz = TIDX; asm volatile("" : "+v"(tzz));
    const int wid = tzz >> 6, lane = tzz & 63, wr = wid >> 2, wc = wid & 3, fr = lane & 15, fq = lane >> 4;
    unsigned so0, so1;
    { int r0, c0, r1, c1; stage_rc(tzz * 16, r0, c0); stage_rc(tzz * 16 + 8192, r1, c1); so0 = (unsigned)(r0 * K + c0); so1 = (unsigned)(r1 * K + c1); }
    f32x4 acc[2][2][4][2];
    int zsrc = 0; asm volatile("" : "+s"(zsrc));
    const float zf0 = __int_as_float(zsrc);
#pragma unroll
    for (int i0 = 0; i0 < 2; ++i0)
#pragma unroll
        for (int i1 = 0; i1 < 2; ++i1)
#pragma unroll
            for (int i2 = 0; i2 < 4; ++i2)
#pragma unroll
                for (int i3 = 0; i3 < 2; ++i3)
#pragma unroll
                    for (int c = 0; c < 4; ++c) acc[i0][i1][i2][i3][c] = zf0;
    bf16x8 At[4][2], B0[2][2], B1[2][2];
    const int nt = K / BK;
    STAGE(SB(0, 0), Bt, bcol, 0); STAGE(SA(0, 0), A, brow, 0);
    STAGE(SB(0, 1), Bt, bcol + HALF, 0); STAGE(SA(0, 1), A, brow + HALF, 0);
    if (wr == 1) BAR;
    WAIT_V(4); BAR;
    STAGE(SB(1, 0), Bt, bcol, 1); STAGE(SA(1, 0), A, brow, 1); STAGE(SB(1, 1), Bt, bcol + HALF, 1);
    WAIT_V(6); BAR;
    for (int t = 0; t < nt - 2; t += 2) {
        LDB(B0, 0, 0); SCHED; LDA(At, 0, 0); STAGE(SA(1, 1), A, brow + HALF, t + 1);
        WAIT_L(8); BAR; WAIT_L(0); MMA(0, 0, At, B0); BAR; SCHED;
        LDB(B1, 0, 1); STAGE(SB(0, 0), Bt, bcol, t + 2);
        BAR; WAIT_L(0); MMA(0, 1, At, B1); BAR;
        LDA(At, 0, 1); STAGE(SA(0, 0), A, brow, t + 2);
        BAR; WAIT_L(0); MMA(1, 0, At, B0); BAR; SCHED;
        STAGE(SB(0, 1), Bt, bcol + HALF, t + 2);
        WAIT_V(6); BAR; MMA(1, 1, At, B1); BAR;
        LDB(B0, 1, 0); SCHED; LDA(At, 1, 0); STAGE(SA(0, 1), A, brow + HALF, t + 2);
        WAIT_L(8); BAR; WAIT_L(0); MMA(0, 0, At, B0); BAR; SCHED;
        LDB(B1, 1, 1); STAGE(SB(1, 0), Bt, bcol, t + 3);
        BAR; WAIT_L(0); MMA(0, 1, At, B1); BAR;
        LDA(At, 1, 1); STAGE(SA(1, 0), A, brow, t + 3);
        BAR; WAIT_L(0); MMA(1, 0, At, B0); BAR; SCHED;
        STAGE(SB(1, 1), Bt, bcol + HALF, t + 3);
        WAIT_V(6); BAR; MMA(1, 1, At, B1); BAR;
    }
    { LDB(B0, 0, 0); LDA(At, 0, 0); STAGE(SA(1, 1), A, brow + HALF, nt - 1);
      BAR; WAIT_L(0); MMA(0, 0, At, B0); BAR;
      LDB(B1, 0, 1); BAR; WAIT_L(0); MMA(0, 1, At, B1); BAR;
      LDA(At, 0, 1); WAIT_V(4); BAR; WAIT_L(0); MMA(1, 0, At, B0); MMA(1, 1, At, B1); BAR; }
    { LDB(B0, 1, 0); LDA(At, 1, 0); WAIT_V(2); BAR; WAIT_L(0); MMA(0, 0, At, B0); BAR;
      LDB(B1, 1, 1); WAIT_V(0); BAR; WAIT_L(0); MMA(0, 1, At, B1); BAR;
      LDA(At, 1, 1); BAR; WAIT_L(0); MMA(1, 0, At, B0); MMA(1, 1, At, B1); BAR; }
    if (wr == 0) BAR;
    epilogue<EPI>(acc, brow, bcol, Cf, Cb, ldc, scale, gvec, XNout, ssq_out, ssq_in, (float*)((char*)shm + 131072));
    __syncthreads();
#undef SA
#undef SB
#undef STAGE
#undef LDA
#undef LDB
#undef MMA
}
#if 0
    if (EPI == EPI_SWIGLU) {
        const int cb = (bcol >> 1) + wc * 32 + fr;
        for (int ai = 0; ai < 2; ++ai) for (int m = 0; m < 4; ++m) for (int n = 0; n < 2; ++n) for (int j = 0; j < 4; ++j) {
            const float g = acc[ai][0][m][n][j], u = acc[ai][1][m][n][j];
            Cb[(size_t)(brow + ai * HALF + wr * 64 + m * 16 + fq * 4 + j) * ldc + cb + n * 16] = f2bf(siluf_(g) * u);
        }
    } else {
        for (int ai = 0; ai < 2; ++ai) for (int bj = 0; bj < 2; ++bj) for (int m = 0; m < 4; ++m) for (int n = 0; n < 2; ++n) for (int j = 0; j < 4; ++j) {
            float* p = Cf + (size_t)(brow + ai * HALF + wr * 64 + m * 16 + fq * 4 + j) * ldc + (bcol + bj * HALF + wc * 32 + n * 16 + fr);
            if (EPI == EPI_RESID) *p += scale * acc[ai][bj][m][n][j]; else *p = acc[ai][bj][m][n][j];
        }
    }
#endif

template <int EPI>
__device__ __forceinline__ void gemm_phase(const bf16_t* A, const bf16_t* Bt, int M, int N, int K, bf16_t* shm,
                                           float* Cf, bf16_t* Cb, int ldc, float scale, const float* gvec, bf16_t* XNout, float* ssq_out, const float* ssq_in) {
    const int nM = M / BM, nN = N / BM, nwg = nM * nN;
    for (int L = BIDX; L < nwg; L += GDIM) {
        int wgid = L;
        { int q = nwg / NXCD, r = nwg % NXCD, xcd = wgid % NXCD, off = wgid / NXCD;
          wgid = (xcd < r ? xcd * (q + 1) : r * (q + 1) + (xcd - r) * q) + off; }
        int nig = WGM * nN, gid = wgid / nig, fm = gid * WGM, gsz = min(nM - fm, WGM);
        int pm = fm + ((wgid % nig) % gsz), pn = (wgid % nig) / gsz;
        gemm_unit<EPI>(A, Bt, K, pm * BM, pn * BM, shm, Cf, Cb, ldc, scale, gvec, XNout, ssq_out, ssq_in);
    }
}
}

typedef __attribute__((address_space(1))) unsigned char* gas_ptr;
__device__ __forceinline__ gas_ptr launder_ws(unsigned char* p, unsigned long long off) { asm volatile("" : "+s"(off)); return (gas_ptr)p + off; }
#define WSP(T, off) ((T*)(__attribute__((address_space(1))) T*)(launder_ws(AWS, (off))))

__device__ __forceinline__ bf16x8 pack8(f32x4 x0, f32x4 x1) {
    u32x4 o; o.x = pk2(x0.x, x0.y); o.y = pk2(x0.z, x0.w); o.z = pk2(x1.x, x1.y); o.w = pk2(x1.z, x1.w);
    return __builtin_bit_cast(bf16x8, o);
}
__device__ __forceinline__ float gelu_tanh(float x) {
    const float u = 0.7978845608028654f * (x + 0.044715f * x * x * x);
    const float e = __expf(2.f * u);
    const float th = 1.f - 2.f / (e + 1.f);
    return 0.5f * x * (1.f + th);
}

__device__ __forceinline__ void nsa_prep_token(const Args& a, int t, int lane) {
    const float* Pr = WSP(const float, WS_P) + (size_t)t * INP;
    const int b = t / SEQ, s = t % SEQ;
    float q1[6], q2[6], kc1[2], kc2[2], vc1[2], vc2[2], ks1[2], ks2[2], kw1[2], kw2[2];
#pragma unroll
    for (int h = 0; h < 6; ++h) { q1[h] = ldnt(Pr + (C_NQ + h * 128 + lane)); q2[h] = ldnt(Pr + (C_NQ + h * 128 + 64 + lane)); }
#pragma unroll
    for (int g = 0; g < 2; ++g) {
        kc1[g] = ldnt(Pr + (C_NKC + g * 128 + lane)); kc2[g] = ldnt(Pr + (C_NKC + g * 128 + 64 + lane));
        vc1[g] = ldnt(Pr + (C_NVC + g * 128 + lane)); vc2[g] = ldnt(Pr + (C_NVC + g * 128 + 64 + lane));
        ks1[g] = ldnt(Pr + (C_NKS + g * 128 + lane)); ks2[g] = ldnt(Pr + (C_NKS + g * 128 + 64 + lane));
        kw1[g] = ldnt(Pr + (C_NKW + g * 128 + lane)); kw2[g] = ldnt(Pr + (C_NKW + g * 128 + 64 + lane));
    }
    const float gt = lane < 18 ? ldnt(Pr + (C_NGT + lane)) : 0.f;
    const float inv = exp2f(-(float)lane * 0.20762050593046014f);
    float sn, cs; sincosf((float)s * inv, &sn, &cs);
    bf16_t* Qb = WSP(bf16_t, WS_QB) + (size_t)t * 768;
    const float scale = 0.08838834764831845f * 1.4426950408889634f;
#pragma unroll
    for (int h = 0; h < 6; ++h) {
        Qb[h * 128 + lane] = f2bf((q1[h] * cs - q2[h] * sn) * scale);
        Qb[h * 128 + 64 + lane] = f2bf((q2[h] * cs + q1[h] * sn) * scale);
    }
#pragma unroll
    for (int g = 0; g < 2; ++g) {
        const size_t ro = ((size_t)(b * 2 + g) * SEQ + s) * 128;
        { float* o = WSP(float, WS_KCR) + ro; o[lane] = kc1[g] * cs - kc2[g] * sn; o[64 + lane] = kc2[g] * cs + kc1[g] * sn; }
        { float* o = WSP(float, WS_VCR) + ro; o[lane] = vc1[g]; o[64 + lane] = vc2[g]; }
        { bf16_t* o = WSP(bf16_t, WS_KS) + ro; o[lane] = f2bf(ks1[g] * cs - ks2[g] * sn); o[64 + lane] = f2bf(ks2[g] * cs + ks1[g] * sn); }
        { bf16_t* o = WSP(bf16_t, WS_KW) + ro; o[lane] = f2bf(kw1[g] * cs - kw2[g] * sn); o[64 + lane] = f2bf(kw2[g] * cs + kw1[g] * sn); }
    }
    if (lane < 18) WSP(float, WS_GT)[(size_t)t * 32 + lane] = sigmoidf_(gt);
}

__device__ __forceinline__ void vtrans_item(const Args& a, int it, unsigned char* lds) {
    const int which = it & 1, tile = (it >> 1) & 63, bg = it >> 7, b = bg >> 1, g = bg & 1;
    const int col = (which ? C_NVW : C_NVS) + g * 128;
    const float* Pp = WSP(const float, WS_P) + (size_t)(b * SEQ + tile * 64) * INP + col;
    float* scr = (float*)lds;
    const int tid = TIDX;
    lds_barrier();
#pragma unroll
    for (int i = 0; i < 16; ++i) { const int idx = i * 512 + tid, tok = idx >> 7, d = idx & 127; scr[d * 65 + tok] = ldnt(Pp + (size_t)tok * INP + d); }
    lds_barrier();
    const int d = tid >> 2, seg = tid & 3;
    const float* s = scr + d * 65 + seg * 16;
    u32x4 o0, o1;
    o0.x = pk2(s[0], s[1]); o0.y = pk2(s[2], s[3]); o0.z = pk2(s[4], s[5]); o0.w = pk2(s[6], s[7]);
    o1.x = pk2(s[8], s[9]); o1.y = pk2(s[10], s[11]); o1.z = pk2(s[12], s[13]); o1.w = pk2(s[14], s[15]);
    bf16_t* dst = WSP(bf16_t, which ? WS_VWT : WS_VST) + ((size_t)bg * 128 + d) * SEQ + tile * 64 + seg * 16;
    *(u32x4*)dst = o0; *(u32x4*)(dst + 8) = o1;
}

__device__ __forceinline__ void gdn_chunk(const Args& a, int l, int ci, unsigned char* lds) {
    const int bh = ci >> 6, n = ci & 63, b = bh / 5, h = bh % 5, tb = b * SEQ + n * 64, s0 = n * 64;
    float* qf = (float*)lds; float* kf = qf + 64 * 128; float* vf = kf + 64 * 128;
    bf16_t* qb = (bf16_t*)(vf + 64 * 128); bf16_t* kb = qb + 64 * 136;
    float* gcs = (float*)(kb + 64 * 136); float* bts = gcs + 64; float* rq = bts + 64; float* rk = rq + 64;
    float* Am = qf;
    const int tid = TIDX, w = tid >> 6, lane = tid & 63, fr = lane & 15, fq = lane >> 4;
    const float* P = WSP(const float, WS_P);
    lds_barrier();
    if (w == 0) {
        const int t = tb + lane;
        const float av = ldnt(P + ((size_t)t * INP + C_GA + h)) + AIN(16)[l * 5 + h];
        const float ev = __expf(av);
        const float sp = av > 20.f ? av : (ev < 0.0625f ? ev * (1.f - ev * (0.5f - ev * (0.33333334f - 0.25f * ev))) : __logf(1.f + ev));
        float g = -__expf(AIN(15)[l * 5 + h]) * sp;
#pragma unroll
        for (int o = 1; o < 64; o <<= 1) { const float x = __shfl_up(g, o); if (lane >= o) g += x; }
        gcs[lane] = g;
        bts[lane] = sigmoidf_(ldnt(P + ((size_t)t * INP + C_GB + h)));
    }
    const int d = tid & 127, cg = tid >> 7;
    {
        const float* cw = AIN(14) + (size_t)l * 4 * 1920;
#pragma unroll
        for (int which = 0; which < 3; ++which) {
            const int col = (which == 0 ? C_GQ : which == 1 ? C_GK : C_GV) + h * 128 + d, cc = which * 640 + h * 128 + d;
            const float w0 = cw[cc], w1 = cw[1920 + cc], w2 = cw[2 * 1920 + cc], w3 = cw[3 * 1920 + cc];
            float* dst = which == 0 ? qf : which == 1 ? kf : vf;
            const int sb = s0 + cg * 16;
            float xm3 = sb >= 3 ? ldnt(P + ((size_t)(tb + cg * 16 - 3) * INP + col)) : 0.f;
            float xm2 = sb >= 2 ? ldnt(P + ((size_t)(tb + cg * 16 - 2) * INP + col)) : 0.f;
            float xm1 = sb >= 1 ? ldnt(P + ((size_t)(tb + cg * 16 - 1) * INP + col)) : 0.f;
#pragma unroll
            for (int i = 0; i < 16; ++i) {
                const float x = ldnt(P + ((size_t)(tb + cg * 16 + i) * INP + col));
                const float y = w0 * xm3 + w1 * xm2 + w2 * xm1 + w3 * x;
                dst[(cg * 16 + i) * 128 + d] = siluf_(y);
                xm3 = xm2; xm2 = xm1; xm1 = x;
            }
        }
    }
    lds_barrier();
#pragma unroll
    for (int rr = 0; rr < 8; ++rr) {
        const int c = w * 8 + rr;
        const float q0 = qf[c * 128 + lane], q1 = qf[c * 128 + 64 + lane], k0 = kf[c * 128 + lane], k1 = kf[c * 128 + 64 + lane];
        const float sq = wave_sum(q0 * q0 + q1 * q1), sk = wave_sum(k0 * k0 + k1 * k1);
        if (lane == 0) { rq[c] = rsqrtf(sq + 1e-6f) * 0.08838834764831845f; rk[c] = rsqrtf(sk + 1e-6f); }
    }
    lds_barrier();
    {
        const float glast = gcs[63];
        unsigned ktv[8];
#pragma unroll
        for (int i = 0; i < 16; ++i) {
            const int c = cg * 16 + i;
            const float qh = qf[c * 128 + d] * rq[c], kh = kf[c * 128 + d] * rk[c], eg = __expf(gcs[c]);
            qb[c * 136 + d] = f2bf(qh); kb[c * 136 + d] = f2bf(kh);
            WSP(bf16_t, WS_GQD)[((size_t)ci * 64 + c) * 128 + d] = f2bf(qh * eg);
            const unsigned short kt = f2bf(kh * __expf(glast - gcs[c]));
            if (i & 1) ktv[i >> 1] |= ((unsigned)kt) << 16; else ktv[i >> 1] = kt;
            kf[c * 128 + d] = kh * bts[c] * eg;
            vf[c * 128 + d] *= bts[c];
        }
        u32x4* dst = (u32x4*)(WSP(bf16_t, WS_GKT) + ((size_t)ci * 128 + d) * 64 + cg * 16);
        dst[0] = (u32x4){ktv[0], ktv[1], ktv[2], ktv[3]}; dst[1] = (u32x4){ktv[4], ktv[5], ktv[6], ktv[7]};
        if (tid == 0) WSP(float, WS_GLAST)[ci] = __expf(glast);
    }
    lds_barrier();
    {
        const int mt = w & 3;
        const bf16_t* Ab = (w < 4) ? kb : qb;
#pragma unroll
        for (int ntile = 0; ntile < 4; ++ntile) {
            f32x4 acc = zero4();
            if (ntile <= mt) {
#pragma unroll
                for (int ks = 0; ks < 4; ++ks) {
                    const bf16x8 av = *(const bf16x8*)(Ab + (mt * 16 + fr) * 136 + ks * 32 + fq * 8);
                    const bf16x8 bv = *(const bf16x8*)(kb + (ntile * 16 + fr) * 136 + ks * 32 + fq * 8);
                    acc = mfma16(av, bv, acc);
                }
            }
#pragma unroll
            for (int j = 0; j < 4; ++j) {
                const int i_ = mt * 16 + 4 * fq + j, j_ = ntile * 16 + fr;
                const float dec = __expf(fminf(gcs[i_] - gcs[j_], 0.f));
                if (w < 4) Am[j_ * 68 + i_] = (j_ < i_) ? bts[i_] * acc[j] * dec : 0.f;
                else WSP(bf16_t, WS_GAT)[((size_t)ci * 64 + i_) * 64 + j_] = f2bf((j_ <= i_) ? acc[j] * dec : 0.f);
            }
        }
    }
    lds_barrier();
    if (tid < 256) {
        const float* rhs = tid < 128 ? vf + tid : kf + (tid - 128);
        float x[64];
#pragma unroll
        for (int i = 0; i < 64; ++i) x[i] = rhs[i * 128];
#pragma unroll
        for (int j = 0; j < 63; ++j) {
            const float xj = x[j];
#pragma unroll
            for (int i4 = (j + 1) / 4; i4 < 16; ++i4) {
                const f32x4 a4 = *(const f32x4*)(Am + j * 68 + 4 * i4);
                if (4 * i4 + 0 > j) x[4 * i4 + 0] -= a4.x * xj;
                if (4 * i4 + 1 > j) x[4 * i4 + 1] -= a4.y * xj;
                if (4 * i4 + 2 > j) x[4 * i4 + 2] -= a4.z * xj;
                if (4 * i4 + 3 > j) x[4 * i4 + 3] -= a4.w * xj;
            }
        }
        if (tid < 128) {
            float* U = WSP(float, WS_GU) + (size_t)ci * 64 * 128 + tid;
#pragma unroll
            for (int i = 0; i < 64; ++i) U[i * 128] = x[i];
        } else {
            bf16_t* Wn = WSP(bf16_t, WS_GWN) + (size_t)ci * 64 * 128 + (tid - 128);
#pragma unroll
            for (int i = 0; i < 64; ++i) Wn[i * 128] = f2bf(-x[i]);
        }
    }
}

__device__ __forceinline__ void hgrn_chunk(const Args& a, int l, int ci, unsigned char* lds) {
    const int bh = ci >> 6, n = ci & 63, b = bh / 5, h = bh % 5, tb = b * SEQ + n * 64;
    bf16_t* qb = (bf16_t*)lds; bf16_t* kb = qb + 64 * 136; float* tot = (float*)(kb + 64 * 136);
    const int tid = TIDX, w = tid >> 6, lane = tid & 63, fr = lane & 15, fq = lane >> 4;
    const int d = tid & 127, cg = tid >> 7;
    const float* P = WSP(const float, WS_P);
    const float lbv = WSP(const float, WS_LB)[l * 640 + h * 128 + d];
    float bl[16], kk[16]; float run = 0.f;
    lds_barrier();
#pragma unroll
    for (int i = 0; i < 16; ++i) {
        const float hf = ldnt(P + (size_t)(tb + cg * 16 + i) * INP + C_HF + h * 128 + d);
        const float f = lbv + (1.f - lbv) * sigmoidf_(hf);
        run += __logf(fmaxf(f, 1e-6f)); bl[i] = run; kk[i] = 1.f - f;
    }
    tot[cg * 128 + d] = run;
    lds_barrier();
    {
        const float t0 = tot[d], t1 = tot[128 + d], t2 = tot[256 + d], t3 = tot[384 + d];
        const float off = (cg > 0 ? t0 : 0.f) + (cg > 1 ? t1 : 0.f) + (cg > 2 ? t2 : 0.f);
        const float blast = t0 + t1 + t2 + t3, bref = t0 + t1;
        unsigned ktv[8], vtv[8];
        float qv[16], hv[16];
#pragma unroll
        for (int i = 0; i < 16; ++i) { const size_t pr = (size_t)(tb + cg * 16 + i) * INP; qv[i] = ldnt(P + pr + C_HQ + h * 128 + d); hv[i] = ldnt(P + pr + C_HI + h * 128 + d); }
#pragma unroll
        for (int i = 0; i < 16; ++i) {
            const int c = cg * 16 + i;
            const float bc = bl[i] + off, q = qv[i];
            qb[c * 136 + d] = f2bf(q * __expf(bc - bref));
            kb[c * 136 + d] = f2bf(kk[i] * __expf(bref - bc));
            WSP(bf16_t, WS_HQE)[((size_t)ci * 64 + c) * 128 + d] = f2bf(q * __expf(bc));
            const unsigned short kt = f2bf(kk[i] * __expf(blast - bc)), vt = f2bf(hv[i]);
            if (i & 1) { ktv[i >> 1] |= ((unsigned)kt) << 16; vtv[i >> 1] |= ((unsigned)vt) << 16; } else { ktv[i >> 1] = kt; vtv[i >> 1] = vt; }
        }
        u32x4* dk = (u32x4*)(WSP(bf16_t, WS_HKT) + ((size_t)ci * 128 + d) * 64 + cg * 16);
        dk[0] = (u32x4){ktv[0], ktv[1], ktv[2], ktv[3]}; dk[1] = (u32x4){ktv[4], ktv[5], ktv[6], ktv[7]};
        u32x4* dv = (u32x4*)(WSP(bf16_t, WS_HVT) + ((size_t)ci * 128 + d) * 64 + cg * 16);
        dv[0] = (u32x4){vtv[0], vtv[1], vtv[2], vtv[3]}; dv[1] = (u32x4){vtv[4], vtv[5], vtv[6], vtv[7]};
        if (cg == 0) WSP(float, WS_HDL)[(size_t)ci * 128 + d] = __expf(blast);
    }
    lds_barrier();
    {
        const int mt = w >> 1;
#pragma unroll
        for (int nn = 0; nn < 2; ++nn) {
            const int ntile = (w & 1) * 2 + nn;
            f32x4 acc = zero4();
            if (ntile <= mt) {
#pragma unroll
                for (int ks = 0; ks < 4; ++ks) {
                    const bf16x8 av = *(const bf16x8*)(qb + (mt * 16 + fr) * 136 + ks * 32 + fq * 8);
                    const bf16x8 bv = *(const bf16x8*)(kb + (ntile * 16 + fr) * 136 + ks * 32 + fq * 8);
                    acc = mfma16(av, bv, acc);
                }
            }
#pragma unroll
            for (int j = 0; j < 4; ++j) {
                const int i_ = mt * 16 + 4 * fq + j, j_ = ntile * 16 + fr;
                WSP(bf16_t, WS_HAM)[((size_t)ci * 64 + i_) * 64 + j_] = f2bf((j_ <= i_) ? acc[j] : 0.f);
            }
        }
    }
}

struct ScanRegs { bf16x8 a10, a11, a12, a13, at0, at1, kt0, kt1, vt0, vt1; f32x4 u; f32x4 dl; };
template <int TYPE>
__device__ __forceinline__ void scan_load(ScanRegs& R, const Args& a, size_t ci, int w, int mt, int fr, int fq, int e0) {
    if (TYPE == 0) {
        {
            const float* U = WSP(const float, WS_GU) + (ci * 64 + mt * 16 + 4 * fq) * 128 + e0 + fr;
            R.u = (f32x4){U[0], U[128], U[256], U[384]};
            const bf16_t* Wn = WSP(const bf16_t, (w < 4) ? WS_GWN : WS_GQD) + (ci * 64 + mt * 16 + fr) * 128 + fq * 8;
            R.a10 = *(const bf16x8*)(Wn); R.a11 = *(const bf16x8*)(Wn + 32); R.a12 = *(const bf16x8*)(Wn + 64); R.a13 = *(const bf16x8*)(Wn + 96);
            const bf16_t* At = WSP(const bf16_t, WS_GAT) + (ci * 64 + mt * 16 + fr) * 64 + fq * 8;
            R.at0 = *(const bf16x8*)(At); R.at1 = *(const bf16x8*)(At + 32);
        }
        const float last = WSP(const float, WS_GLAST)[ci];
        R.dl = (f32x4){last, last, last, last};
        const bf16_t* Kt = WSP(const bf16_t, WS_GKT) + (ci * 128 + 16 * w + fr) * 64 + fq * 8;
        R.kt0 = *(const bf16x8*)(Kt); R.kt1 = *(const bf16x8*)(Kt + 32);
    } else {
        const bf16_t* Vt = WSP(const bf16_t, WS_HVT) + (ci * 128 + e0 + fr) * 64 + fq * 8;
        R.vt0 = __builtin_nontemporal_load((const bf16x8*)(Vt)); R.vt1 = __builtin_nontemporal_load((const bf16x8*)(Vt + 32));
        if (w >= 4) {
            const bf16_t* Qd = WSP(const bf16_t, WS_HQE) + (ci * 64 + mt * 16 + fr) * 128 + fq * 8;
            R.a10 = *(const bf16x8*)(Qd); R.a11 = *(const bf16x8*)(Qd + 32); R.a12 = *(const bf16x8*)(Qd + 64); R.a13 = *(const bf16x8*)(Qd + 96);
            const bf16_t* At = WSP(const bf16_t, WS_HAM) + (ci * 64 + mt * 16 + fr) * 64 + fq * 8;
            R.at0 = *(const bf16x8*)(At); R.at1 = *(const bf16x8*)(At + 32);
        }
        R.dl = *(const f32x4*)(WSP(const float, WS_HDL) + ci * 128 + 16 * w + 4 * fq);
        const bf16_t* Kt = WSP(const bf16_t, WS_HKT) + (ci * 128 + 16 * w + fr) * 64 + fq * 8;
        R.kt0 = *(const bf16x8*)(Kt); R.kt1 = *(const bf16x8*)(Kt + 32);
    }
}
template <int TYPE>
__device__ __forceinline__ void scan_step(const ScanRegs& R, const Args& a, f32x4& Sacc, bf16_t* St, bf16_t* Vn, int w, int mt, int fr, int fq, float* Orow) {
    f32x4 oacc = zero4();
    bf16x8 bv0, bv1;
    if (TYPE == 0) {
        if (w < 4) {
            f32x4 acc = R.u;
            { const bf16_t* sp = St + fr * 136 + fq * 8;
              acc = mfma16(R.a10, *(const bf16x8*)(sp), acc); acc = mfma16(R.a11, *(const bf16x8*)(sp + 32), acc);
              acc = mfma16(R.a12, *(const bf16x8*)(sp + 64), acc); acc = mfma16(R.a13, *(const bf16x8*)(sp + 96), acc); }
            u32x2 o; o.x = pk2(acc[0], acc[1]); o.y = pk2(acc[2], acc[3]);
            *(u32x2*)(Vn + fr * 72 + mt * 16 + 4 * fq) = o;
        } else {
            { const bf16_t* sp = St + fr * 136 + fq * 8;
              oacc = mfma16(R.a10, *(const bf16x8*)(sp), oacc); oacc = mfma16(R.a11, *(const bf16x8*)(sp + 32), oacc);
              oacc = mfma16(R.a12, *(const bf16x8*)(sp + 64), oacc); oacc = mfma16(R.a13, *(const bf16x8*)(sp + 96), oacc); }
        }
        lds_barrier();
        bv0 = *(const bf16x8*)(Vn + fr * 72 + fq * 8); bv1 = *(const bf16x8*)(Vn + fr * 72 + 32 + fq * 8);
    } else {
        bv0 = R.vt0; bv1 = R.vt1;
        if (w >= 4) {
            { const bf16_t* sp = St + fr * 136 + fq * 8;
              oacc = mfma16(R.a10, *(const bf16x8*)(sp), oacc); oacc = mfma16(R.a11, *(const bf16x8*)(sp + 32), oacc);
              oacc = mfma16(R.a12, *(const bf16x8*)(sp + 64), oacc); oacc = mfma16(R.a13, *(const bf16x8*)(sp + 96), oacc); }
        }
        lds_barrier();
    }
    if (w >= 4) {
        oacc = mfma16(R.at0, bv0, oacc);
        oacc = mfma16(R.at1, bv1, oacc);
#pragma unroll
        for (int j = 0; j < 4; ++j) Orow[(size_t)j * 640] = oacc[j];
    }
    Sacc = Sacc * R.dl;
    Sacc = mfma16(R.kt0, bv0, Sacc);
    Sacc = mfma16(R.kt1, bv1, Sacc);
    u32x2 o; o.x = pk2(Sacc[0], Sacc[1]); o.y = pk2(Sacc[2], Sacc[3]);
    *(u32x2*)(St + fr * 136 + 16 * w + 4 * fq) = o;
    lds_barrier();
}
template <int TYPE>
__device__ __forceinline__ void scan_task(const Args& a, int task, unsigned char* lds) {
    const int bh = task >> 3, es = task & 7, e0 = es * 16, b = bh / 5, h = bh % 5;
    const int tid = TIDX, w = __builtin_amdgcn_readfirstlane(tid >> 6), lane = tid & 63, fr = lane & 15, fq = lane >> 4;
    bf16_t* St = (bf16_t*)lds;
    bf16_t* Vn = St + 16 * 136;
    __syncthreads();
    for (int i = tid; i < 16 * 136; i += 512) St[i] = 0;
    f32x4 Sacc = zero4();
    const int mt = w & 3;
    float* Obase = WSP(float, TYPE == 0 ? WS_OG : WS_OH) + ((size_t)(b * SEQ + mt * 16 + 4 * fq)) * 640 + h * 128 + e0 + fr;
    ScanRegs R0, R1;
    scan_load<TYPE>(R0, a, (size_t)bh * 64, w, mt, fr, fq, e0);
    __syncthreads();
    for (int n = 0; n < NCH; n += 2) {
        scan_load<TYPE>(R1, a, (size_t)bh * 64 + n + 1, w, mt, fr, fq, e0);
        scan_step<TYPE>(R0, a, Sacc, St, Vn, w, mt, fr, fq, Obase + (size_t)n * 64 * 640);
        scan_load<TYPE>(R0, a, (size_t)bh * 64 + (n + 2 < NCH ? n + 2 : NCH - 1), w, mt, fr, fq, e0);
        scan_step<TYPE>(R1, a, Sacc, St, Vn, w, mt, fr, fq, Obase + (size_t)(n + 1) * 64 * 640);
    }
}

__device__ __forceinline__ void compress_item(const Args& a, int l, int it, unsigned char* lds, unsigned* cmp_done) {
    const int which = it >> 6, bg = (it >> 4) & 3, rg = it & 15;
    const int tid = TIDX, w = tid >> 6, lane = tid & 63, fr = lane & 15, fq = lane >> 4;
    const float* X = WSP(const float, which ? WS_VCR : WS_KCR) + (size_t)bg * SEQ * 128;
    const float* pe = sel_ptr(which != 0, AIN(9), AIN(8)) + (size_t)l * 32 * 128;
    const bf16_t* W1t = WSP(const bf16_t, which ? WS_CV1 : WS_CK1);
    const bf16_t* W2t = WSP(const bf16_t, which ? WS_CV2 : WS_CK2);
    bf16_t* Hs = (bf16_t*)lds;
    float* Part = (float*)(lds + 8192);
    const int nc = rg * 16 + fr, ncl = nc < 255 ? nc : 254;
    const float* arow = X + (size_t)ncl * 16 * 128 + w * 512 + fq * 8;
    const bf16_t* brow = W1t + (size_t)fr * 4096 + w * 512 + fq * 8;
    const float* per = pe + w * 512 + fq * 8;
    f32x4 acc[8];
#pragma unroll
    for (int nt = 0; nt < 8; ++nt) acc[nt] = zero4();
    __syncthreads();
#pragma unroll 2
    for (int kk = 0; kk < 16; ++kk) {
        const f32x4 x0 = *(const f32x4*)(arow + kk * 32), x1 = *(const f32x4*)(arow + kk * 32 + 4);
        const f32x4 p0 = *(const f32x4*)(per + kk * 32), p1 = *(const f32x4*)(per + kk * 32 + 4);
        bf16x8 bfr[8];
#pragma unroll
        for (int nt = 0; nt < 8; ++nt) bfr[nt] = *(const bf16x8*)(brow + (size_t)nt * 16 * 4096 + kk * 32);
        const bf16x8 av = pack8(x0 + p0, x1 + p1);
#pragma unroll
        for (int nt = 0; nt < 8; ++nt) acc[nt] = mfma16(av, bfr[nt], acc[nt]);
    }
#pragma unroll
    for (int nt = 0; nt < 8; ++nt)
#pragma unroll
        for (int j = 0; j < 4; ++j) Part[(w * 16 + fq * 4 + j) * 132 + nt * 16 + fr] = acc[nt][j];
    __syncthreads();
    {
        const int row = tid >> 5, c4 = (tid & 31) * 4;
        f32x4 sum = *(const f32x4*)(Part + row * 132 + c4);
#pragma unroll
        for (int ww = 1; ww < 8; ++ww) sum = sum + *(const f32x4*)(Part + (ww * 16 + row) * 132 + c4);
        u32x2 o; o.x = pk2(gelu_tanh(sum.x), gelu_tanh(sum.y)); o.y = pk2(gelu_tanh(sum.z), gelu_tanh(sum.w));
        *(u32x2*)(Hs + row * 136 + c4) = o;
    }
    __syncthreads();
    f32x4 acc2 = zero4();
#pragma unroll
    for (int ks = 0; ks < 4; ++ks)
        acc2 = mfma16(*(const bf16x8*)(Hs + fr * 136 + ks * 32 + fq * 8), *(const bf16x8*)(W2t + (size_t)(w * 16 + fr) * 128 + ks * 32 + fq * 8), acc2);
    const int dcol = w * 16 + fr;
    if (which == 0) {
#pragma unroll
        for (int j = 0; j < 4; ++j) { const int r = rg * 16 + fq * 4 + j; WSP(bf16_t, WS_KCB)[((size_t)bg * 256 + r) * 128 + dcol] = r < 255 ? f2bf(acc2[j]) : (bf16_t)0; }
    } else {
        const int r0 = rg * 16 + fq * 4;
        u32x2 o; o.x = pk2(acc2[0], acc2[1]); o.y = pk2(acc2[2], (r0 + 3 < 255) ? acc2[3] : 0.f);
        *(u32x2*)(WSP(bf16_t, WS_VCT) + ((size_t)bg * 128 + dcol) * 256 + r0) = o;
    }
    asm volatile("s_waitcnt vmcnt(0)" ::: "memory");
    __syncthreads();
    if (TIDX == 0) { __builtin_amdgcn_fence(__ATOMIC_RELEASE, "agent"); asm volatile("s_waitcnt vmcnt(0)" ::: "memory"); xb_add(cmp_done, 1u); }
}

constexpr int AT_K = 0;
constexpr int AT_V = 2 * 64 * 136 * 2;
constexpr int AT_PW = AT_V + 2 * 128 * 72 * 2;
constexpr int AT_MASK = AT_PW + 8 * 16 * 72 * 2;
constexpr int AT_WM = AT_MASK + 128 * 8;
constexpr int AT_PC = 0;
static_assert(8 * 16 * 264 * 2 <= AT_PW, "PC alias");
constexpr int AT_IMP = AT_WM + 64;
constexpr int AT_END = AT_IMP + 8 * 16 * 64 * 4;
static_assert(AT_END <= LDS_BYTES, "attention LDS");

__device__ __forceinline__ float rmax16(float v) {
    v = fmaxf(v, __shfl_xor(v, 1)); v = fmaxf(v, __shfl_xor(v, 2)); v = fmaxf(v, __shfl_xor(v, 4)); v = fmaxf(v, __shfl_xor(v, 8));
    return v;
}
__device__ __forceinline__ float rsum16(float v) {
    v += __shfl_xor(v, 1); v += __shfl_xor(v, 2); v += __shfl_xor(v, 4); v += __shfl_xor(v, 8);
    return v;
}

struct TileRegs { u32x4 k[2], v[2]; };
__device__ __forceinline__ void tile_load(TileRegs& r, const bf16_t* Kg, const bf16_t* Vtg, int kb) {
    const int tid = TIDX;
#pragma unroll
    for (int i = 0; i < 2; ++i) {
        const int idx = tid + i * 512;
        r.k[i] = *(const u32x4*)(Kg + ((size_t)kb * 64 + (idx >> 4)) * 128 + (idx & 15) * 8);
        r.v[i] = *(const u32x4*)(Vtg + (size_t)(idx >> 3) * SEQ + kb * 64 + (idx & 7) * 8);
    }
}
__device__ __forceinline__ void tile_store(const TileRegs& r, bf16_t* Ks, bf16_t* Vs) {
    const int tid = TIDX;
#pragma unroll
    for (int i = 0; i < 2; ++i) {
        const int idx = tid + i * 512;
        *(u32x4*)(Ks + (idx >> 4) * 136 + (idx & 15) * 8) = r.k[i];
        const int c = idx & 7, s0 = (c >> 2) * 32 + ((2 * c) & 3) * 8 + ((c >> 1) & 1) * 4;
        bf16_t* vr = Vs + (idx >> 3) * 72;
        *(u32x2*)(vr + s0) = (u32x2){r.v[i].x, r.v[i].y};
        *(u32x2*)(vr + s0 + 8) = (u32x2){r.v[i].z, r.v[i].w};
    }
}

constexpr int RING_SLOT = 32768, RING_V = 16384;
__device__ __forceinline__ void tile_dma(unsigned char* lds, int slot, const bf16_t* Kg, const bf16_t* Vtg, int kb, int tid) {
    unsigned char* kd = lds + slot * RING_SLOT; unsigned char* vd = kd + RING_V;
#pragma unroll
    for (int i = 0; i < 2; ++i) {
        const int q = i * 512 + tid;
        { const int rs = q >> 4, pos = q & 15, c = pos ^ (rs & 15), nt = rs >> 4, r16 = rs & 15;
          const int keyl = 32 * (nt >> 1) + 8 * (r16 >> 2) + 4 * (nt & 1) + (r16 & 3);
          __builtin_amdgcn_global_load_lds((const unsigned*)(Kg + ((size_t)kb * 64 + keyl) * 128 + c * 8),
                                           (__attribute__((address_space(3))) unsigned*)(kd + q * 16), 16, 0, 0); }
        { const int d = q >> 3, pos = q & 7, c = pos ^ ((d >> 1) & 7);
          __builtin_amdgcn_global_load_lds((const unsigned*)(Vtg + (size_t)d * SEQ + kb * 64 + c * 8),
                                           (__attribute__((address_space(3))) unsigned*)(vd + q * 16), 16, 0, 0); }
    }
}
template <int MODE>
__device__ __forceinline__ void attn_compute(const bf16x8 (&qf)[4], const unsigned char* Ks, const unsigned char* Vs, int kb, int tok,
                                             unsigned long long msk, f32x4 (&O)[8], float& mrow, float& lrow) {
    const int lane = TIDX & 63, fr = lane & 15, fq = lane >> 4;
    if (MODE == 1) {
        if (__builtin_amdgcn_ballot_w64(((msk >> kb) & 1ull) != 0ull) == 0ull) return;
    }
    f32x4 S[4];
    {
        bf16x8 kf[16];
#pragma unroll
        for (int i = 0; i < 16; ++i) kf[i] = *(const bf16x8*)(Ks + ((i >> 2) * 16 + fr) * 256 + ((((i & 3) * 4 + fq) ^ fr) * 16));
        __builtin_amdgcn_sched_barrier(0);
#pragma unroll
        for (int nt = 0; nt < 4; ++nt) {
            S[nt] = zero4();
#pragma unroll
            for (int ks = 0; ks < 4; ++ks) S[nt] = mfma16(kf[nt * 4 + ks], qf[ks], S[nt]);
        }
    }
    bf16x8 vf[16];
#pragma unroll
    for (int i = 0; i < 16; ++i) vf[i] = *(const bf16x8*)(Vs + ((i & 7) * 16 + fr) * 128 + ((((i >> 3) * 4 + fq) ^ ((fr >> 1) & 7)) * 16));
    const bool rowok = (MODE == 0) ? true : (((msk >> kb) & 1ull) != 0ull);
    const int key0 = kb * 64 + 8 * fq;
    const int tb = __builtin_amdgcn_readfirstlane(tok - fr);
    const bool interior = (kb * 64 + 63 <= tb) && (MODE == 1 || kb * 64 > tb + 15 - 512);
    float mx = -1e30f;
    if (interior) {
#pragma unroll
        for (int nt = 0; nt < 4; ++nt)
#pragma unroll
            for (int c = 0; c < 4; ++c) {
                if (MODE == 1) S[nt][c] = rowok ? S[nt][c] : -1e30f;
                mx = fmaxf(mx, S[nt][c]);
            }
    } else {
#pragma unroll
        for (int nt = 0; nt < 4; ++nt)
#pragma unroll
            for (int c = 0; c < 4; ++c) {
                const int key = key0 + 32 * (nt >> 1) + 4 * (nt & 1) + c;
                const bool ok = rowok && (key <= tok) && (MODE == 1 || key > tok - 512);
                S[nt][c] = ok ? S[nt][c] : -1e30f;
                mx = fmaxf(mx, S[nt][c]);
            }
    }
    mx = fmaxf(mx, __shfl_xor(mx, 16)); mx = fmaxf(mx, __shfl_xor(mx, 32));
    const float mnew = fmaxf(mrow, mx), alpha = __builtin_amdgcn_exp2f(mrow - mnew);
    mrow = mnew;
    float ps = 0.f;
    if (MODE == 0 && interior) {
#pragma unroll
        for (int nt = 0; nt < 4; ++nt)
#pragma unroll
            for (int c = 0; c < 4; ++c) { const float p = __builtin_amdgcn_exp2f(S[nt][c] - mnew); S[nt][c] = p; ps += p; }
    } else {
#pragma unroll
        for (int nt = 0; nt < 4; ++nt)
#pragma unroll
            for (int c = 0; c < 4; ++c) {
                const float p = (S[nt][c] > -1e29f) ? __builtin_amdgcn_exp2f(S[nt][c] - mnew) : 0.f;
                S[nt][c] = p; ps += p;
            }
    }
    lrow = lrow * alpha + ps;
#pragma unroll
    for (int dt = 0; dt < 8; ++dt) O[dt] = O[dt] * alpha;
#pragma unroll
    for (int kk = 0; kk < 2; ++kk) {
        u32x4 pw; pw.x = pk2(S[2 * kk][0], S[2 * kk][1]); pw.y = pk2(S[2 * kk][2], S[2 * kk][3]);
        pw.z = pk2(S[2 * kk + 1][0], S[2 * kk + 1][1]); pw.w = pk2(S[2 * kk + 1][2], S[2 * kk + 1][3]);
        const bf16x8 pb = __builtin_bit_cast(bf16x8, pw);
#pragma unroll
        for (int dt = 0; dt < 8; ++dt) O[dt] = mfma16(vf[kk * 8 + dt], pb, O[dt]);
    }
}

template <int MODE>
__device__ __forceinline__ void attn_head(const bf16_t* qptr, const bf16_t* Kg, const bf16_t* Vtg, unsigned long long un, int tok,
                                          unsigned long long msk, unsigned char* lds, f32x4 (&O)[8], float& lrow) {
    const int tid = TIDX;
    bf16x8 qf[4];
#pragma unroll
    for (int ks = 0; ks < 4; ++ks) qf[ks] = *(const bf16x8*)(qptr + ks * 32);
    float mrow = -1e30f; lrow = 0.f;
#pragma unroll
    for (int dt = 0; dt < 8; ++dt) O[dt] = zero4();
    const int n = __builtin_popcountll(un);
    unsigned long long remc = un, remp = un;
    int kpre = __builtin_ctzll(remp); remp &= remp - 1;
    lds_barrier();
    tile_dma(lds, 0, Kg, Vtg, kpre, tid);
    if (remp) { kpre = __builtin_ctzll(remp); remp &= remp - 1; }
    tile_dma(lds, 1, Kg, Vtg, kpre, tid);
    int slot = 0;
    for (int i = 0; i < n; ++i) {
        const int kb = __builtin_ctzll(remc); remc &= remc - 1;
        asm volatile("s_waitcnt vmcnt(4)" ::: "memory");
        __builtin_amdgcn_s_barrier();
        asm volatile("" ::: "memory");
        if (remp) { kpre = __builtin_ctzll(remp); remp &= remp - 1; }
        int ps = slot + 2; ps = ps >= 3 ? ps - 3 : ps;
        tile_dma(lds, ps, Kg, Vtg, kpre, tid);
        attn_compute<MODE>(qf, lds + slot * RING_SLOT, lds + slot * RING_SLOT + RING_V, kb, tok, msk, O, mrow, lrow);
        asm volatile("s_waitcnt lgkmcnt(0)" ::: "memory");
        slot = slot == 2 ? 0 : slot + 1;
    }
    asm volatile("s_waitcnt vmcnt(0)" ::: "memory");
    lrow += __shfl_xor(lrow, 16); lrow += __shfl_xor(lrow, 32);
}

__device__ __forceinline__ void load_q(bf16x8 (&qf)[4], const Args& a, int t, int head) {
    const int lane = TIDX & 63, fr = lane & 15, fq = lane >> 4;
    const bf16_t* q = WSP(const bf16_t, WS_QB) + (size_t)(t + fr) * 768 + head * 128 + fq * 8;
#pragma unroll
    for (int ks = 0; ks < 4; ++ks) qf[ks] = *(const bf16x8*)(q + ks * 32);
}

__device__ __forceinline__ void window_item(const Args& a, int it, unsigned char* lds) {
    const int qt = it & 31, bh = it >> 5, b = bh / 6, hd = bh % 6, g = hd / 3, r = hd % 3, bg = b * 2 + g, t0 = qt * 128;
    const int tid = TIDX, w = tid >> 6, lane = tid & 63, fr = lane & 15, fq = lane >> 4;
    const bf16_t* Kg = WSP(const bf16_t, WS_KW) + (size_t)bg * SEQ * 128;
    const bf16_t* Vtg = WSP(const bf16_t, WS_VWT) + (size_t)bg * 128 * SEQ;
    const int tokbase = t0 + 16 * w;
    const bf16_t* qptr = WSP(const bf16_t, WS_QB) + (size_t)(b * SEQ + tokbase + fr) * 768 + hd * 128 + fq * 8;
    f32x4 O[8]; float lrow;
    const int kb_lo = (t0 >> 6) >= 8 ? (t0 >> 6) - 8 : 0, kb_hi = (t0 >> 6) + 1;
    const unsigned long long un = ((kb_hi >= 63) ? ~0ull : ((1ull << (kb_hi + 1)) - 1ull)) & ~((1ull << kb_lo) - 1ull);
    attn_head<0>(qptr, Kg, Vtg, un, tokbase + fr, 0ull, lds, O, lrow);
    const float* GT = WSP(const float, WS_GT);
    float* On = WSP(float, WS_ONSA);
    {
        const int t = b * SEQ + tokbase + fr;
        const float sc = GT[(size_t)t * 32 + g * 9 + r * 3 + 2] / fmaxf(lrow, 1e-30f);
#pragma unroll
        for (int dt = 0; dt < 8; ++dt) *(f32x4*)(On + (size_t)t * 768 + hd * 128 + dt * 16 + 4 * fq) = O[dt] * sc;
    }
}

__device__ __forceinline__ void cmpsel_item(const Args& a, int it, unsigned char* lds, unsigned* cmp_done) {
    const int bg = it & 3, qt = 31 - (it >> 2), b = bg >> 1, g = bg & 1, t0 = qt * 128;
    const int tid = TIDX, w = tid >> 6, lane = tid & 63, fr = lane & 15, fq = lane >> 4;
    const int tokbase = t0 + 16 * w;
    const float* GT = WSP(const float, WS_GT);
    float* On = WSP(float, WS_ONSA);
    float* Oc2 = WSP(float, WS_ONC);
    bf16_t* Pc = (bf16_t*)(lds + AT_PC) + w * 16 * 264;
    float* imps = (float*)(lds + AT_IMP) + w * 16 * 64;
    unsigned long long* maskL = (unsigned long long*)(lds + AT_MASK);
    unsigned long long* wmL = (unsigned long long*)(lds + AT_WM);
    __syncthreads();
    if (TIDX == 0) { unsigned sp = 0; while (xb_ld(cmp_done) < 128u && sp < (1u << 22)) { __builtin_amdgcn_s_sleep(2); ++sp; } }
    __syncthreads();
    __builtin_amdgcn_fence(__ATOMIC_ACQUIRE, "agent");
    asm volatile("s_waitcnt vmcnt(0)" ::: "memory");
    {
        const bf16_t* Kc = WSP(const bf16_t, WS_KCB) + (size_t)bg * 256 * 128;
        const bf16_t* Vc = WSP(const bf16_t, WS_VCT) + (size_t)bg * 128 * 256;
#pragma unroll 1
        for (int r = 0; r < 3; ++r) {
            int lz = lane; asm volatile("" : "+v"(lz));
            const int lane = lz, fr = lz & 15, fq = lz >> 4;
            bf16x8 qf[4];
            { const bf16_t* q = WSP(const bf16_t, WS_QB) + (size_t)(b * SEQ + tokbase + fr) * 768 + (g * 3 + r) * 128 + fq * 8;
#pragma unroll
              for (int ks = 0; ks < 4; ++ks) qf[ks] = *(const bf16x8*)(q + ks * 32); }
            f32x4 S[16];
            const int tmaxw = __builtin_amdgcn_readfirstlane(tokbase) + 15;
#pragma unroll
            for (int g4 = 0; g4 < 4; ++g4) {
#pragma unroll
                for (int n4 = 0; n4 < 4; ++n4) S[g4 * 4 + n4] = zero4();
                if (1024 * g4 + 31 <= tmaxw) {
                    bf16x8 kf[16];
#pragma unroll
                    for (int i = 0; i < 16; ++i) kf[i] = *(const bf16x8*)(Kc + (size_t)((g4 * 4 + (i >> 2)) * 16 + fr) * 128 + (i & 3) * 32 + fq * 8);
#pragma unroll
                    for (int n4 = 0; n4 < 4; ++n4) {
#pragma unroll
                        for (int ks = 0; ks < 4; ++ks) S[g4 * 4 + n4] = mfma16(qf[ks], kf[n4 * 4 + ks], S[g4 * 4 + n4]);
                    }
                }
            }
#pragma unroll
            for (int j = 0; j < 4; ++j) {
                const int tok = tokbase + fq * 4 + j;
                float mx = -1e30f;
#pragma unroll
                for (int nt = 0; nt < 16; ++nt) { const int n = nt * 16 + fr; if (n < 255 && 16 * n + 31 <= tok) mx = fmaxf(mx, S[nt][j]); }
                mx = rmax16(mx);
                float ps = 0.f;
#pragma unroll
                for (int nt = 0; nt < 16; ++nt) { const int n = nt * 16 + fr; const float p = (n < 255 && 16 * n + 31 <= tok) ? __builtin_amdgcn_exp2f(S[nt][j] - mx) : 0.f; S[nt][j] = p; ps += p; }
                ps = rsum16(ps);
                const float inv = 1.f / fmaxf(ps, 1e-30f);
#pragma unroll
                for (int nt = 0; nt < 16; ++nt) { const float p = S[nt][j] * inv; S[nt][j] = p; Pc[(fq * 4 + j) * 264 + nt * 16 + fr] = f2bf(p); }
            }
            asm volatile("s_waitcnt lgkmcnt(0)" ::: "memory");
#pragma unroll
            for (int nt = 0; nt < 16; ++nt)
#pragma unroll
                for (int j = 0; j < 4; ++j) {
                    const float v = S[nt][j];
                    float s4 = v + __shfl_xor(v, 1); s4 += __shfl_xor(s4, 2);
                    const float p3 = __shfl(v, lane | 3);
                    const float up = __shfl(v, (lane + 63) & 63);
                    const float vprev = nt > 0 ? S[nt > 0 ? nt - 1 : 0][j] : 0.f;
                    const float upp = __shfl(vprev, lane | 15);
                    const float pm1 = (fr == 0) ? upp : up;
                    if ((fr & 3) == 0) {
                        float* ip = imps + (fq * 4 + j) * 64 + nt * 4 + (fr >> 2);
                        const float val = s4 - 0.5f * p3 + 0.5f * pm1;
                        *ip = (r == 0) ? val : (*ip + val);
                    }
                }
            f32x4 Oc[8];
            float gcv[4];
#pragma unroll
            for (int j = 0; j < 4; ++j) gcv[j] = GT[(size_t)(b * SEQ + tokbase + fq * 4 + j) * 32 + g * 9 + r * 3 + 0];
#pragma unroll
            for (int dt = 0; dt < 8; ++dt) Oc[dt] = zero4();
#pragma unroll
            for (int half = 0; half < 2; ++half)
#pragma unroll
                for (int kg = 0; kg < 2; ++kg) {
                    if (2048 * kg + 31 > tmaxw) continue;
                    bf16x8 vf[16];
#pragma unroll
                    for (int i = 0; i < 16; ++i) vf[i] = *(const bf16x8*)(Vc + (size_t)((half * 4 + (i & 3)) * 16 + fr) * 256 + (kg * 4 + (i >> 2)) * 32 + fq * 8);
#pragma unroll
                    for (int k4 = 0; k4 < 4; ++k4) {
                        const bf16x8 av = *(const bf16x8*)(Pc + fr * 264 + (kg * 4 + k4) * 32 + fq * 8);
#pragma unroll
                        for (int dt = 0; dt < 4; ++dt) Oc[half * 4 + dt] = mfma16(av, vf[k4 * 4 + dt], Oc[half * 4 + dt]);
                    }
                }
#pragma unroll
            for (int j = 0; j < 4; ++j) {
                const int t = b * SEQ + tokbase + fq * 4 + j;
#pragma unroll
                for (int dt = 0; dt < 8; ++dt) Oc2[(size_t)t * 768 + (g * 3 + r) * 128 + dt * 16 + fr] = gcv[j] * Oc[dt][j];
            }
            asm volatile("s_waitcnt lgkmcnt(0)" ::: "memory");
        }
    }
    asm volatile("s_waitcnt lgkmcnt(0)" ::: "memory");
    {
        const int tk = lane >> 2, sub = lane & 3, tok = tokbase + tk, cur = tok >> 6;
        float* myimp = imps + tk * 64;
#pragma unroll
        for (int k4 = 0; k4 < 4; ++k4) {
            f32x4 v = *(const f32x4*)(myimp + sub * 16 + k4 * 4);
#pragma unroll
            for (int e = 0; e < 4; ++e) {
                const int m = sub * 16 + k4 * 4 + e;
                if (m > cur) v[e] = -1e9f;
                if (m == 0 || m == cur || m == cur - 1) v[e] = 1e9f;
            }
            *(f32x4*)(myimp + sub * 16 + k4 * 4) = v;
        }
        asm volatile("s_waitcnt lgkmcnt(0)" ::: "memory");
        int all[64];
#pragma unroll
        for (int m4 = 0; m4 < 16; ++m4) {
            const f32x4 v = *(const f32x4*)(myimp + m4 * 4);
#pragma unroll
            for (int e = 0; e < 4; ++e) {
                const unsigned u = __float_as_uint(v[e]);
                const unsigned ord = (u & 0x80000000u) ? ~u : (u | 0x80000000u);
                all[m4 * 4 + e] = (int)((((ord >> 1) & ~63u)) | (unsigned)(63 - (m4 * 4 + e)));
            }
        }
        unsigned part = 0;
#pragma unroll 1
        for (int k = 0; k < 16; ++k) {
            const int mi = sub * 16 + k;
            const unsigned u = __float_as_uint(((volatile float*)myimp)[mi]);
            const unsigned ord = (u & 0x80000000u) ? ~u : (u | 0x80000000u);
            const int kmi = (int)((((ord >> 1) & ~63u)) | (unsigned)(63 - mi));
            unsigned rank = 0;
#pragma unroll
            for (int m = 0; m < 64; ++m) rank += ((unsigned)(kmi - all[m])) >> 31;
            if (rank < 16u) part |= 1u << k;
        }
        unsigned long long mk = ((unsigned long long)part) << (sub * 16);
        unsigned lo = (unsigned)mk, hi = (unsigned)(mk >> 32);
        lo |= __shfl_xor(lo, 1); hi |= __shfl_xor(hi, 1); lo |= __shfl_xor(lo, 2); hi |= __shfl_xor(hi, 2);
        mk = ((unsigned long long)hi << 32) | lo;
        if (sub == 0) maskL[w * 16 + tk] = mk;
        unsigned ulo = lo, uhi = hi;
#pragma unroll
        for (int o = 4; o < 64; o <<= 1) { ulo |= __shfl_xor(ulo, o); uhi |= __shfl_xor(uhi, o); }
        if (lane == 0) wmL[w] = ((unsigned long long)uhi << 32) | ulo;
    }
    __syncthreads();
    unsigned long long un = 0;
#pragma unroll
    for (int i = 0; i < 8; ++i) un |= wmL[i];
    { const int kmax = (t0 + 127) >> 6; un &= (kmax >= 63) ? ~0ull : ((1ull << (kmax + 1)) - 1ull); }
    {
        unsigned long long* MG = WSP(unsigned long long, WS_MSK) + (size_t)(bg * 32 + qt) * 130;
        if (TIDX < 128) MG[TIDX] = maskL[TIDX];
        if (TIDX == 128) MG[128] = un;
    }
}

__device__ __forceinline__ void sel_head_item(const Args& a, int it, unsigned char* lds) {
    const int qt = 31 - it / 12, sub = it % 12, bg = sub & 3, r = sub >> 2, b = bg >> 1, g = bg & 1, t0 = qt * 128;
    const int tid = TIDX, w = tid >> 6, lane = tid & 63, fr = lane & 15, fq = lane >> 4;
    const int tokbase = t0 + 16 * w;
    const unsigned long long* MG = WSP(const unsigned long long, WS_MSK) + (size_t)(bg * 32 + qt) * 130;
    unsigned long long un = MG[128];
    un = ((unsigned long long)__builtin_amdgcn_readfirstlane((unsigned)(un >> 32)) << 32) | (unsigned)__builtin_amdgcn_readfirstlane((unsigned)un);
    const unsigned long long msk = MG[w * 16 + fr];
    const float* GT = WSP(const float, WS_GT);
    const float* On = WSP(const float, WS_ONSA);
    const float* Oc2 = WSP(const float, WS_ONC);
    const bf16_t* Kg = WSP(const bf16_t, WS_KS) + (size_t)bg * SEQ * 128;
    const bf16_t* Vtg = WSP(const bf16_t, WS_VST) + (size_t)bg * 128 * SEQ;
    bf16_t* Y = WSP(bf16_t, WS_Y);
    const bf16_t* qptr = WSP(const bf16_t, WS_QB) + (size_t)(b * SEQ + tokbase + fr) * 768 + (g * 3 + r) * 128 + fq * 8;
    f32x4 O[8]; float lrow;
    attn_head<1>(qptr, Kg, Vtg, un, tokbase + fr, msk, lds, O, lrow);
    {
        const int t = b * SEQ + tokbase + fr;
        const float sc = GT[(size_t)t * 32 + g * 9 + r * 3 + 1] / fmaxf(lrow, 1e-30f);
        f32x4 pv[8];
#pragma unroll
        for (int dt = 0; dt < 8; ++dt) {
            const size_t o = (size_t)t * 768 + (g * 3 + r) * 128 + dt * 16 + 4 * fq;
            pv[dt] = __builtin_nontemporal_load((const f32x4*)(On + o)) + __builtin_nontemporal_load((const f32x4*)(Oc2 + o));
        }
#pragma unroll
        for (int dt = 0; dt < 8; ++dt) {
            const f32x4 v = pv[dt] + O[dt] * sc;
            u32x2 pk; pk.x = pk2(v.x, v.y); pk.y = pk2(v.z, v.w);
            *(u32x2*)(Y + (size_t)t * DM + (g * 3 + r) * 128 + dt * 16 + 4 * fq) = pk;
        }
    }
}

__device__ __forceinline__ void post_item(const Args& a, int l, int it) {
    const int w = TIDX >> 6, lane = TIDX & 63;
    const float* P = WSP(const float, WS_P);
    bf16_t* Y = WSP(bf16_t, WS_Y);
    const float* nwg = AIN(17) + l * 128; const float* nwh = AIN(19) + l * 128;
    const float ng0 = nwg[lane], ng1 = nwg[64 + lane], nh0 = nwh[lane], nh1 = nwh[64 + lane];
#pragma unroll 1
    for (int tk = 0; tk < 4; ++tk) {
        const int t = it * 32 + w * 4 + tk;
        float o0[10], o1[10], z0[10], z1[10];
#pragma unroll
        for (int hh = 0; hh < 10; ++hh) {
            const int ty = hh / 5, h = hh % 5;
            const float* O = WSP(const float, ty ? WS_OH : WS_OG) + (size_t)t * 640 + h * 128;
            const float* z = P + (size_t)t * INP + (ty ? C_HG : C_GZ) + h * 128;
            o0[hh] = ldnt(O + lane); o1[hh] = ldnt(O + 64 + lane); z0[hh] = ldnt(z + lane); z1[hh] = ldnt(z + 64 + lane);
        }
#pragma unroll
        for (int hh = 0; hh < 10; ++hh) {
            const int ty = hh / 5, h = hh % 5;
            const float rs = rsqrtf(wave_sum(o0[hh] * o0[hh] + o1[hh] * o1[hh]) * (1.f / 128.f) + 1e-6f);
            bf16_t* y = Y + (size_t)t * DM + 768 + ty * 640 + h * 128;
            y[lane] = f2bf(o0[hh] * rs * (ty ? nh0 : ng0) * siluf_(z0[hh]));
            y[64 + lane] = f2bf(o1[hh] * rs * (ty ? nh1 : ng1) * siluf_(z1[hh]));
        }
    }
}

#ifndef PROBE_K
#define PROBE_K -1
#define PROBE_N 0
#endif
#ifndef PROBE_SUB
#define PROBE_SUB 15
#endif
#ifndef MULTI_LAUNCH
#define MULTI_LAUNCH 0
#endif
constexpr int DYN_LDS = 140 * 1024;
constexpr int N_PHASES = DEPTH * 12 + 1;

__device__ __forceinline__ int fetch_item(unsigned* ctr, unsigned char* lds) {
    volatile int* slot = (volatile int*)(lds + DYN_LDS - 16);
    lds_barrier();
    if (TIDX == 0) *slot = (int)atomicAdd(ctr, 1u);
    lds_barrier();
    const int v = *slot;
    return __builtin_amdgcn_readfirstlane(v);
}

struct ConvDesc { int in_idx; size_t src_off; int K, N; size_t dst_off; int mode, r; };
__device__ __forceinline__ void conv_decode(int T, int l, ConvDesc& d) {
    constexpr int TG = 32 * 44, TD = 88 * 16, TI = 32 * 59, TO = 32 * 16, TC1 = 64 * 1, TC2 = 2 * 1;
    const size_t lw = (size_t)l * DM * FF;
    int r = T;
    if (r < TG) { d = ConvDesc{2, lw, DM, FF, WS_WGU1, 1, r}; return; } r -= TG;
    if (r < TG) { d = ConvDesc{3, lw, DM, FF, WS_WGU1, 2, r}; return; } r -= TG;
    if (r < TD) { d = ConvDesc{4, lw, FF, DM, WS_WD1, 0, r}; return; } r -= TD;
    if (r < TG) { d = ConvDesc{21, lw, DM, FF, WS_WGU2, 1, r}; return; } r -= TG;
    if (r < TG) { d = ConvDesc{22, lw, DM, FF, WS_WGU2, 2, r}; return; } r -= TG;
    if (r < TD) { d = ConvDesc{23, lw, FF, DM, WS_WD2, 0, r}; return; } r -= TD;
    if (r < TI) { d = ConvDesc{6, (size_t)l * DM * INW, DM, INW, WS_WIN, 3, r}; return; } r -= TI;
    if (r < TO) { d = ConvDesc{7, (size_t)l * DM * DM, DM, DM, WS_WOUT, 0, r}; return; } r -= TO;
    if (r < TC1) { d = ConvDesc{10, (size_t)l * 4096 * 128, 4096, 128, WS_CK1, 0, r}; return; } r -= TC1;
    if (r < TC1) { d = ConvDesc{12, (size_t)l * 4096 * 128, 4096, 128, WS_CV1, 0, r}; return; } r -= TC1;
    if (r < TC2) { d = ConvDesc{11, (size_t)l * 128 * 128, 128, 128, WS_CK2, 0, r}; return; } r -= TC2;
    d = ConvDesc{13, (size_t)l * 128 * 128, 128, 128, WS_CV2, 0, r};
}
__device__ __forceinline__ void conv_load(const ConvDesc& d, f32x4 (&v)[4], int tid) {
    const float* W = (const float*)(__attribute__((address_space(1))) const float*)karg_u64(8 * d.in_idx) + d.src_off;
    const int nbn = (d.N + 127) / 128, kb = d.r / nbn, nb = d.r % nbn, k0 = kb * 64, n0 = nb * 128;
#pragma unroll
    for (int i = 0; i < 4; ++i) {
        const int idx = i * 512 + tid, kk = idx >> 5, n4 = (idx & 31) * 4;
        v[i] = zero4();
        if (n0 + n4 < d.N) v[i] = __builtin_nontemporal_load((const f32x4*)(W + (size_t)(k0 + kk) * d.N + n0 + n4));
    }
}
__device__ __forceinline__ void conv_store(const Args& a, const ConvDesc& d, const f32x4 (&v)[4], float* scr, int tid) {
    const int nbn = (d.N + 127) / 128, kb = d.r / nbn, nb = d.r % nbn, k0 = kb * 64, n0 = nb * 128;
    lds_barrier();
#pragma unroll
    for (int i = 0; i < 4; ++i) {
        const int idx = i * 512 + tid, kk = idx >> 5, n4 = (idx & 31) * 4;
        scr[(n4 + 0) * 65 + kk] = v[i].x; scr[(n4 + 1) * 65 + kk] = v[i].y; scr[(n4 + 2) * 65 + kk] = v[i].z; scr[(n4 + 3) * 65 + kk] = v[i].w;
    }
    lds_barrier();
#pragma unroll
    for (int h = 0; h < 2; ++h) {
        const int nn = h * 64 + (tid >> 3), kc = (tid & 7) * 8;
        if (n0 + nn < d.N) {
            const float* sp = scr + nn * 65 + kc;
            u32x4 o; o.x = pk2(sp[0], sp[1]); o.y = pk2(sp[2], sp[3]); o.z = pk2(sp[4], sp[5]); o.w = pk2(sp[6], sp[7]);
            *(u32x4*)(WSP(bf16_t, d.dst_off) + (size_t)rowmap(d.mode, n0 + nn) * d.K + k0 + kc) = o;
        }
    }
}
__device__ __forceinline__ void phase_convert(const Args& a, int l, unsigned char* lds) {
    float* scr = (float*)lds;
    constexpr int TG = 32 * 44, TD = 88 * 16, TI = 32 * 59, TO = 32 * 16, TC1 = 64 * 1, TC2 = 2 * 1;
    constexpr int TOTAL = 4 * TG + 2 * TD + TI + TO + 2 * TC1 + 2 * TC2;
    {
        const int tid = TIDX, G = GDIM;
        int T = BIDX;
        ConvDesc d0{}; f32x4 v[4];
        v[0] = zero4(); v[1] = zero4(); v[2] = zero4(); v[3] = zero4();
        if (T < TOTAL) { conv_decode(T, l, d0); conv_load(d0, v, tid); }
        while (T < TOTAL) {
            const int Tn = T + G;
            ConvDesc d1{}; f32x4 vn[4];
            vn[0] = zero4(); vn[1] = zero4(); vn[2] = zero4(); vn[3] = zero4();
            if (Tn < TOTAL) { conv_decode(Tn, l, d1); conv_load(d1, vn, tid); }
            conv_store(a, d0, v, scr, tid);
            d0 = d1; v[0] = vn[0]; v[1] = vn[1]; v[2] = vn[2]; v[3] = vn[3]; T = Tn;
        }
    }
    {
        u32x4* z = (u32x4*)(WSP(bf16_t, WS_WIN) + (size_t)INW * DM);
        const int nz = (INP - INW) * DM * 2 / 16;
        for (int i = BIDX * 512 + TIDX; i < nz; i += GDIM * 512) z[i] = __builtin_bit_cast(u32x4, zero4());
    }
    if (BIDX == 0) {
        for (int i = TIDX; i < 640; i += 512) {
            const float x0 = AIN(18)[i], x1 = AIN(18)[640 + i], m = fmaxf(x0, x1);
            const float e0 = __expf(x0 - m), e1 = __expf(x1 - m);
            WSP(float, WS_LB)[i] = 0.f; WSP(float, WS_LB)[640 + i] = e1 / (e0 + e1);
        }
    }
}

__device__ __forceinline__ void phase_rms_first(const Args& a, int l) {
    if (l != 0) return;
    const int lane = TIDX & 63, gw = BIDX * 8 + (TIDX >> 6), ngw = GDIM * 8;
    const float* g = AIN(1);
    float* ssq = WSP(float, WS_SSQ);
    bf16_t* XN = WSP(bf16_t, WS_XN);
    for (int r = gw; r < NT; r += ngw) {
        const f32x4* xr = (const f32x4*)(AIN(0) + (size_t)r * DM) + lane; f32x4* o = (f32x4*)(AOUT + (size_t)r * DM) + lane;
        u32x2* xo = (u32x2*)(XN + (size_t)r * DM) + lane;
        float s = 0.f;
        f32x4 vv[8], gv[8];
#pragma unroll
        for (int j = 0; j < 8; ++j) { vv[j] = __builtin_nontemporal_load(xr + 64 * j); gv[j] = ((const f32x4*)g)[lane + 64 * j]; }
#pragma unroll
        for (int j = 0; j < 8; ++j) {
            const f32x4 v = vv[j], gg = gv[j]; o[64 * j] = v;
            s += v.x * v.x + v.y * v.y + v.z * v.z + v.w * v.w;
            u32x2 w; w.x = pk2(v.x * gg.x, v.y * gg.y); w.y = pk2(v.z * gg.z, v.w * gg.w);
            xo[64 * j] = w;
        }
        s = wave_sum(s);
        if (lane < 8) ssq[(size_t)r * 8 + lane] = lane == 0 ? s : 0.f;
    }
}

__device__ __forceinline__ void phase_final(const Args& a) {
    const int lane = TIDX & 63, gw = BIDX * 8 + (TIDX >> 6), ngw = GDIM * 8;
    f32x4 gg[8];
#pragma unroll
    for (int j = 0; j < 8; ++j) gg[j] = ((const f32x4*)AIN(24))[lane + 64 * j];
    for (int r = gw; r < NT; r += ngw) {
        f32x4* xr = (f32x4*)(AOUT + (size_t)r * DM) + lane;
        f32x4 v[8]; float s = 0.f;
#pragma unroll
        for (int j = 0; j < 8; ++j) { v[j] = __builtin_nontemporal_load(xr + 64 * j); s += v[j].x * v[j].x + v[j].y * v[j].y + v[j].z * v[j].z + v[j].w * v[j].w; }
        const float rs = rsqrtf(wave_sum(s) * (1.f / DM) + 1e-6f);
#pragma unroll
        for (int j = 0; j < 8; ++j) xr[64 * j] = v[j] * rs * gg[j];
    }
}

template <int k>
__device__ __forceinline__ void run_phase_k(const Args& a, int l, unsigned char* lds, int& seq, int sub = 15) {
    bf16_t* shm = (bf16_t*)lds;
    const int gw = BIDX * 8 + (TIDX >> 6), ngw = GDIM * 8;
    unsigned* ctl = WSP(unsigned, WS_CTL);
    if (k == 12) { phase_final(a); return; }
    if (k == 0) { phase_convert(a, l, lds); phase_rms_first(a, l); }
    if (k == 1) gm::gemm_phase<gm::EPI_SWIGLU>(WSP(bf16_t, WS_XN), WSP(bf16_t, WS_WGU1), NT, 2 * FF, DM, shm, nullptr, WSP(bf16_t, WS_P), FF, 0.f, nullptr, nullptr, nullptr, WSP(const float, WS_SSQ) + (size_t)(l * 3 + 0) * NT * 8);
    if (k == 2) gm::gemm_phase<gm::EPI_RESID>(WSP(bf16_t, WS_P), WSP(bf16_t, WS_WD1), NT, DM, FF, shm, AOUT, nullptr, DM, 0.5f, AIN(5) + l * DM, WSP(bf16_t, WS_XN), WSP(float, WS_SSQ) + (size_t)(l * 3 + 1) * NT * 8, nullptr);
    if (k == 4) gm::gemm_phase<gm::EPI_STORE>(WSP(bf16_t, WS_XN), WSP(bf16_t, WS_WIN), NT, INP, DM, shm, WSP(float, WS_P), nullptr, INP, 0.f, nullptr, nullptr, nullptr, WSP(const float, WS_SSQ) + (size_t)(l * 3 + 1) * NT * 8);
    if (k == 5) {
        while (true) {
            const int it = fetch_item(ctl + 128 + l, lds);
            if (it >= 640 + 640 + 512 + 256) break;
            if (it < 640) { if (sub & 1) gdn_chunk(a, l, it, lds); }
            else if (it < 1280) { if (sub & 2) hgrn_chunk(a, l, it - 640, lds); }
            else if (it < 1792) { if (sub & 4) vtrans_item(a, it - 1280, lds); }
            else { if (sub & 8) { for (int q = 0; q < 4; ++q) nsa_prep_token(a, (it - 1792) * 32 + q * 8 + (TIDX >> 6), TIDX & 63); } }
        }
    }
    if (k == 6) {
        while (true) {
            const int it = fetch_item(ctl + seq, lds);
            if (it >= 128 + 160 + 128 + 384) break;
            if (it < 128) { if (sub & 2) compress_item(a, l, it, lds, ctl + 64 + seq); }
            else if (it < 288) { if (sub & 1) { if (it - 128 < 80) scan_task<0>(a, it - 128, lds); else scan_task<1>(a, it - 208, lds); } }
            else if (it < 416) { if (sub & 8) cmpsel_item(a, it - 288, lds, (sub & 2) ? ctl + 64 + seq : ctl + 64); }
            else { if (sub & 4) window_item(a, it - 416, lds); }
        }
        ++seq;
    }
    if (k == 7) {
        while (true) {
            const int it = fetch_item(ctl + seq, lds);
            if (it >= 384 + 256) break;
            if (it < 384) sel_head_item(a, it, lds); else post_item(a, l, it - 384);
        }
        ++seq;
    }
    if (k == 8) gm::gemm_phase<gm::EPI_RESID>(WSP(bf16_t, WS_Y), WSP(bf16_t, WS_WOUT), NT, DM, DM, shm, AOUT, nullptr, DM, 1.0f, AIN(20) + l * DM, WSP(bf16_t, WS_XN), WSP(float, WS_SSQ) + (size_t)(l * 3 + 2) * NT * 8, nullptr);
    if (k == 10) gm::gemm_phase<gm::EPI_SWIGLU>(WSP(bf16_t, WS_XN), WSP(bf16_t, WS_WGU2), NT, 2 * FF, DM, shm, nullptr, WSP(bf16_t, WS_P), FF, 0.f, nullptr, nullptr, nullptr, WSP(const float, WS_SSQ) + (size_t)(l * 3 + 2) * NT * 8);
    if (k == 11) {
        if (l + 1 < DEPTH) gm::gemm_phase<gm::EPI_RESID>(WSP(bf16_t, WS_P), WSP(bf16_t, WS_WD2), NT, DM, FF, shm, AOUT, nullptr, DM, 0.5f, AIN(1) + (l + 1) * DM, WSP(bf16_t, WS_XN), WSP(float, WS_SSQ) + (size_t)((l + 1) * 3 + 0) * NT * 8, nullptr);
        else gm::gemm_phase<gm::EPI_RESID>(WSP(bf16_t, WS_P), WSP(bf16_t, WS_WD2), NT, DM, FF, shm, AOUT, nullptr, DM, 0.5f, nullptr, nullptr, nullptr, nullptr);
    }
}

__device__ __forceinline__ void run_phase(const Args& a, int ph, unsigned char* lds, int& seq, int sub = 15) {
    if (ph == DEPTH * 12) { run_phase_k<12>(a, 0, lds, seq); return; }
    const int l = ph / 12, k = ph % 12;
    switch (k) {
    case 0: run_phase_k<0>(a, l, lds, seq); break;
    case 1: run_phase_k<1>(a, l, lds, seq); break;
    case 2: run_phase_k<2>(a, l, lds, seq); break;
    case 3: run_phase_k<3>(a, l, lds, seq); break;
    case 4: run_phase_k<4>(a, l, lds, seq); break;
    case 5: run_phase_k<5>(a, l, lds, seq, sub); break;
    case 6: run_phase_k<6>(a, l, lds, seq, sub); break;
    case 7: run_phase_k<7>(a, l, lds, seq); break;
    case 8: run_phase_k<8>(a, l, lds, seq); break;
    case 9: run_phase_k<9>(a, l, lds, seq); break;
    case 10: run_phase_k<10>(a, l, lds, seq); break;
    case 11: run_phase_k<11>(a, l, lds, seq); break;
    }
}

template <int k>
__global__ __launch_bounds__(512, 2) void phk(Args a) {
    extern __shared__ __attribute__((aligned(16))) unsigned char lds[];
    int seq = (a.ph_lo / 12) * 2 + ((a.ph_lo % 12) == 7 ? 1 : 0);
    run_phase_k<k>(a, a.ph_lo / 12, lds, seq);
}

#define XB_TMO      128
#define XB_XCNT(j)  (256  + 64 * (j))
#define XB_XSUB(j)  (1280 + 64 * (j))
#define XB_XGEN(j)  (2304 + 64 * (j))
#define XB_TOP      3328
#define XB_TOPGEN   3392
#define XB_SPIN_CAP (1u << 20)
#define LAS3 __attribute__((address_space(3)))
__device__ __forceinline__ unsigned xb_xcc_id() { return (unsigned)__builtin_amdgcn_s_getreg((3 << 11) | 20) & 0xFu; }
#define XB_SPIN(cond, bar) do { unsigned _sp = 0; while (cond) { __builtin_amdgcn_s_sleep(1); \
    if ((++_sp & 255u) == 0u) { if (xb_ld(&(bar)[XB_TMO])) break; if (_sp > XB_SPIN_CAP) { atomicAdd(&(bar)[XB_TMO], 1u); break; } } } } while (0)
struct XcdBarrier { unsigned* bar; unsigned x; volatile LAS3 unsigned* st; };
__device__ __forceinline__ XcdBarrier xcd_barrier_post(unsigned* bar, volatile LAS3 unsigned* st) {
    XcdBarrier b; b.bar = bar; b.x = xb_xcc_id(); b.st = st;
    if (threadIdx.x == 0) (void)xb_add(&bar[XB_XCNT(b.x)], 1u);
    return b;
}
__device__ __forceinline__ void xcd_barrier_complete(unsigned* bar, unsigned x, unsigned& nloc, unsigned& nx) {
    const unsigned G = gridDim.x * gridDim.y * gridDim.z;
    unsigned sum, cnt, mine, sp = 0u;
    for (;;) {
        sum = 0u; cnt = 0u; mine = 0u;
#pragma unroll
        for (unsigned j = 0; j < 16; ++j) { const unsigned c = xb_ld(&bar[XB_XCNT(j)]); sum += c; cnt += (c > 0u) ? 1u : 0u; mine = (j == x) ? c : mine; }
        if (sum == G) break;
        __builtin_amdgcn_s_sleep(1);
        if ((++sp & 255u) == 0u) { if (xb_ld(&bar[XB_TMO])) break; if (sp > XB_SPIN_CAP) { atomicAdd(&bar[XB_TMO], 1u); break; } }
    }
    nloc = mine > 0u ? mine : 1u; nx = cnt > 0u ? cnt : 1u;
}
__device__ __forceinline__ void xcd_barrier(const XcdBarrier& b) {
    asm volatile("s_waitcnt vmcnt(0)" ::: "memory");
    __syncthreads();
    if (threadIdx.x == 0) {
        unsigned* bar = b.bar;
        __builtin_amdgcn_s_waitcnt(0);
        unsigned nloc = b.st[0], nx = b.st[1];
        if (nloc == 0u) { xcd_barrier_complete(bar, b.x, nloc, nx); b.st[0] = nloc; b.st[1] = nx; }
        const unsigned old = xb_add(&bar[XB_XSUB(b.x)], 1u);
        const unsigned gen = old / nloc;
        if (old + 1u == (gen + 1u) * nloc) {
            __builtin_amdgcn_fence(__ATOMIC_RELEASE, "agent");
            asm volatile("s_waitcnt vmcnt(0)" ::: "memory");
            const unsigned og = xb_add(&bar[XB_TOP], 1u);
            const unsigned tg = og / nx;
            if (og + 1u == (tg + 1u) * nx) xb_add(&bar[XB_TOPGEN], 1u);
            else XB_SPIN(xb_ld(&bar[XB_TOPGEN]) == tg, bar);
            __builtin_amdgcn_fence(__ATOMIC_ACQUIRE, "agent");
            xb_add(&bar[XB_XGEN(b.x)], 1u);
            asm volatile("s_waitcnt vmcnt(0)" ::: "memory");
        } else {
            XB_SPIN(xb_ld(&bar[XB_XGEN(b.x)]) == gen, bar);
            __builtin_amdgcn_fence(__ATOMIC_ACQUIRE, "agent");
            asm volatile("s_waitcnt vmcnt(0)" ::: "memory");
        }
    }
    __syncthreads();
}

#if !MULTI_LAUNCH
__global__ __launch_bounds__(512, 2) void mega(Args a) {
    extern __shared__ __attribute__((aligned(16))) unsigned char lds[];
    cg::grid_group grid = cg::this_grid();
    volatile LAS3 unsigned* xst = (volatile LAS3 unsigned*)(lds + DYN_LDS - 64);
    if (threadIdx.x == 0) { xst[0] = 0u; xst[1] = 0u; }
    __syncthreads();
    XcdBarrier xb = xcd_barrier_post((unsigned*)(a.ws + WS_BAR), xst);
#define SEAM(ph) do { if ((ph) == a.ph_lo) grid.sync(); else xcd_barrier(xb); } while (0)
    int seq = 0;
    for (int ph = a.ph_lo; ph < a.ph_hi; ++ph) {
        if (ph < DEPTH * 12 && ((ph % 12) == 3 || (ph % 12) == 9)) continue;
        run_phase(a, ph, lds, seq);
#if PROBE_N > 0
        if (PROBE_K >= 0 && ph < DEPTH * 12 && (ph % 12) == PROBE_K) for (int rep = 0; rep < PROBE_N; ++rep) { SEAM(ph); run_phase(a, ph, lds, seq, PROBE_SUB); }
        if (PROBE_K == -2 && ph + 1 < a.ph_hi) for (int rep = 0; rep < PROBE_N; ++rep) SEAM(ph);
#endif
        if (ph + 1 < a.ph_hi) SEAM(ph);
    }
}
#define MAINK mega
#else
#define MAINK phk<0>
#endif

extern "C" void kernel_launch(void* const* d_in, const int* in_sizes, int n_in, void* d_out, int out_size, void* d_ws, size_t ws_size, hipStream_t stream) {
    static int grid = 0;
    if (grid == 0) {
        if (n_in != 25 || out_size != NT * DM || ws_size < WS_END) {
            fprintf(stderr, "kernel_launch: unexpected shapes: n_in %d out %d ws %zu (need %zu)\n", n_in, out_size, ws_size, (size_t)WS_END);
            grid = -1; return;
        }
        int dev = 0, cus = 0, per_cu = 0;
        hipGetDevice(&dev);
        hipDeviceGetAttribute(&cus, hipDeviceAttributeMultiprocessorCount, dev);
        if (hipFuncSetAttribute((const void*)MAINK, hipFuncAttributeMaxDynamicSharedMemorySize, DYN_LDS) != hipSuccess) { fprintf(stderr, "kernel_launch: hipFuncSetAttribute failed\n"); grid = -1; return; }
#if MULTI_LAUNCH
#define SK(K) (void)hipFuncSetAttribute((const void*)phk<K>, hipFuncAttributeMaxDynamicSharedMemorySize, DYN_LDS);
        SK(0) SK(1) SK(2) SK(3) SK(4) SK(5) SK(6) SK(7) SK(8) SK(9) SK(10) SK(11) SK(12)
#undef SK
#endif
        if (hipOccupancyMaxActiveBlocksPerMultiprocessor(&per_cu, (const void*)MAINK, 512, DYN_LDS) != hipSuccess || per_cu < 1) { per_cu = 1; (void)hipGetLastError(); }
        grid = cus * per_cu;
        if (grid <= 0) grid = 256;
    }
    if (grid < 0) return;
    (void)hipMemsetAsync((char*)d_ws + WS_CTL, 0, 32768, stream);
    Args a{};
    for (int i = 0; i < 25; ++i) a.in[i] = (const float*)d_in[i];
    a.out = (float*)d_out; a.ws = (unsigned char*)d_ws;
#if MULTI_LAUNCH
    for (int ph = 0; ph < N_PHASES; ++ph) {
        a.ph_lo = ph; a.ph_hi = ph + 1;
        const int k = ph == DEPTH * 12 ? 12 : ph % 12;
#define LK(K) case K: hipLaunchKernelGGL(phk<K>, dim3(grid), dim3(512), DYN_LDS, stream, a); break;
        switch (k) { LK(0) LK(1) LK(2) LK(3) LK(4) LK(5) LK(6) LK(7) LK(8) LK(9) LK(10) LK(11) LK(12) }
#undef LK
    }
#else
    a.ph_lo = 0; a.ph_hi = N_PHASES;
    void* args[] = {&a};
    hipError_t e = hipLaunchCooperativeKernel((const void*)MAINK, dim3(grid), dim3(512), args, DYN_LDS, stream);
    if (e != hipSuccess) fprintf(stderr, "cooperative launch failed: %s (grid %d)\n", hipGetErrorString(e), grid);
#endif
}
```
